# Optimizing an MI355X kernel written in HIP

```python
import jax, jax.numpy as jnp
from jax import lax
import numpy as np

D_MODEL = 1024
BATCH = 4
SEQ = 8192
DEPTH = 1

HEAD_DIM = 64
FOX_HEADS = 8
SWA_HEADS = 8
SWA_KV_HEADS = 2
SWA_GROUP = SWA_HEADS // SWA_KV_HEADS
WINDOW = 128
Q_BLOCK = 128
ROPE_THETA = 10000.0
N_GROUPS = 8
EXPERTS_PER_GROUP = 8
N_EXPERTS = N_GROUPS * EXPERTS_PER_GROUP
TOP_K = 2
D_EXPERT = D_MODEL // 2
MOE_BLOCK = 128
EPS = 1e-6

FOX_W = FOX_HEADS * HEAD_DIM
SWA_W = SWA_HEADS * HEAD_DIM
SWA_KV_W = SWA_KV_HEADS * HEAD_DIM
IN_SPLITS = (FOX_W, FOX_W, FOX_W, FOX_HEADS, SWA_W, SWA_KV_W, SWA_KV_W, D_MODEL, D_MODEL)
N_IN = sum(IN_SPLITS)
SPLIT_POINTS = tuple(int(v) for v in np.cumsum(IN_SPLITS)[:-1])

kernel_name = "hybrid_fox_swa_sink_hier_moe"


def rms_norm(x, g):
    xf = x.astype(jnp.float32)
    y = xf * lax.rsqrt(jnp.mean(xf * xf, axis=-1, keepdims=True) + EPS)
    return (y * g.astype(jnp.float32)).astype(x.dtype)


def rotary(x, positions):
    half = HEAD_DIM // 2
    inv_freq = ROPE_THETA ** (-jnp.arange(half, dtype=jnp.float32) * 2.0 / HEAD_DIM)
    ang = positions.astype(jnp.float32)[..., None] * inv_freq
    cos = jnp.cos(ang)[:, :, None, :]
    sin = jnp.sin(ang)[:, :, None, :]
    xf = x.astype(jnp.float32)
    x1, x2 = xf[..., :half], xf[..., half:]
    return jnp.concatenate([x1 * cos - x2 * sin, x2 * cos + x1 * sin], axis=-1).astype(x.dtype)


def fox_attention(q, k, v, log_f):
    B, S, H, Dh = q.shape
    nb = S // Q_BLOCK
    c = jnp.cumsum(log_f, axis=1)
    c_k = jnp.transpose(c, (0, 2, 1))
    q_blocks = q.reshape(B, nb, Q_BLOCK, H, Dh).transpose(1, 0, 2, 3, 4)
    c_blocks = c.reshape(B, nb, Q_BLOCK, H).transpose(1, 0, 3, 2)
    key_pos = jnp.arange(S)
    scale = HEAD_DIM ** -0.5

    def one_block(args):
        qb, cb, i = args
        s = jnp.einsum('bqhd,bkhd->bhqk', qb, k).astype(jnp.float32) * scale
        s = s + cb[..., None] - c_k[:, :, None, :]
        q_pos = i * Q_BLOCK + jnp.arange(Q_BLOCK)
        causal = key_pos[None, :] <= q_pos[:, None]
        p = jax.nn.softmax(jnp.where(causal, s, -jnp.inf), axis=-1)
        return jnp.einsum('bhqk,bkhd->bqhd', p.astype(v.dtype), v)

    o = lax.map(one_block, (q_blocks, c_blocks, jnp.arange(nb)))
    return o.transpose(1, 0, 2, 3, 4).reshape(B, S, H * Dh)


def swa_sink_attention(q, k, v, sinks):
    B, S, _, Dh = q.shape
    nb = S // WINDOW
    qb = q.reshape(B, nb, WINDOW, SWA_KV_HEADS, SWA_GROUP, Dh)

    def with_prev(t):
        t = t.reshape(B, nb, WINDOW, SWA_KV_HEADS, Dh)
        prev = jnp.pad(t[:, :-1], ((0, 0), (1, 0), (0, 0), (0, 0), (0, 0)))
        return jnp.concatenate([prev, t], axis=2)

    kw, vw = with_prev(k), with_prev(v)
    s = jnp.einsum('bnqhgd,bnkhd->bnhgqk', qb, kw).astype(jnp.float32) * (HEAD_DIM ** -0.5)
    i = jnp.arange(WINDOW)[:, None]
    j = jnp.arange(2 * WINDOW)[None, :]
    dist = WINDOW + i - j
    band = (dist >= 0) & (dist < WINDOW)
    valid = jnp.where((jnp.arange(nb) == 0)[:, None, None], band & (j >= WINDOW), band)
    s = jnp.where(valid[None, :, None, None], s, -jnp.inf)
    sink = jnp.broadcast_to(
        sinks.astype(jnp.float32).reshape(SWA_KV_HEADS, SWA_GROUP)[None, None, :, :, None, None],
        s.shape[:-1] + (1,))
    p = jax.nn.softmax(jnp.concatenate([s, sink], axis=-1), axis=-1)[..., :-1]
    o = jnp.einsum('bnhgqk,bnkhd->bnqhgd', p.astype(v.dtype), vw)
    return o.reshape(B, S, SWA_HEADS * Dh)


def hybrid_mixer(h, positions, w_in, b_forget, b_gate, sinks, w_proj_fox, w_proj_swa, w_out):
    B, S, _ = h.shape
    proj = h @ w_in
    q_f, k_f, v_f, f_logit, q_s, k_s, v_s, gl_f, gl_s = jnp.split(proj, SPLIT_POINTS, axis=-1)
    heads = lambda t, n: t.reshape(B, S, n, HEAD_DIM)
    log_f = jax.nn.log_sigmoid(f_logit.astype(jnp.float32) + b_forget.astype(jnp.float32))
    o_f = fox_attention(heads(q_f, FOX_HEADS), heads(k_f, FOX_HEADS), heads(v_f, FOX_HEADS), log_f)
    o_s = swa_sink_attention(rotary(heads(q_s, SWA_HEADS), positions),
                             rotary(heads(k_s, SWA_KV_HEADS), positions),
                             heads(v_s, SWA_KV_HEADS), sinks)
    g_f = jax.nn.sigmoid(gl_f + b_gate[0])
    g_s = jax.nn.sigmoid(gl_s + b_gate[1])
    merged = g_f * (o_f @ w_proj_fox) + g_s * (o_s @ w_proj_swa)
    return merged @ w_out


def hier_moe(h, w_group, b_group, w_expert, b_expert, w1, w3, w2):
    B, S, D = h.shape
    T = B * S
    hf = h.reshape(T, D)
    g_prob = jax.nn.softmax((hf @ w_group).astype(jnp.float32) + b_group.astype(jnp.float32), axis=-1)
    g_w, g_idx = lax.top_k(g_prob, 1)
    e_logits = ((hf @ w_expert).astype(jnp.float32) + b_expert.astype(jnp.float32)
                ).reshape(T, N_GROUPS, EXPERTS_PER_GROUP)
    e_sel = e_logits[jnp.arange(T), g_idx[:, 0]]
    top_v, top_i = lax.top_k(e_sel, TOP_K)
    gate = (g_w * jax.nn.softmax(top_v, axis=-1)).reshape(-1)
    expert_id = (g_idx * EXPERTS_PER_GROUP + top_i).reshape(-1)
    token_id = jnp.repeat(jnp.arange(T, dtype=jnp.int32), TOP_K)
    A = T * TOP_K
    order = jnp.argsort(expert_id)
    e_sorted = expert_id[order]
    counts = jnp.bincount(expert_id, length=N_EXPERTS)
    padded = (counts + MOE_BLOCK - 1) // MOE_BLOCK * MOE_BLOCK
    start = jnp.cumsum(counts) - counts
    pad_end = jnp.cumsum(padded)
    pad_start = pad_end - padded
    dest = pad_start[e_sorted] + jnp.arange(A) - start[e_sorted]
    P = A + N_EXPERTS * MOE_BLOCK
    n_blk = P // MOE_BLOCK
    row_token = jnp.full((P,), T, jnp.int32).at[dest].set(token_id[order])
    row_gate = jnp.zeros((P,), jnp.float32).at[dest].set(gate[order])
    blk_expert = jnp.minimum(jnp.searchsorted(pad_end, jnp.arange(n_blk) * MOE_BLOCK, side='right'),
                             N_EXPERTS - 1)
    h_pad = jnp.concatenate([hf, jnp.zeros((1, D), hf.dtype)], axis=0)
    xs = h_pad[row_token].reshape(n_blk, MOE_BLOCK, D)

    def expert_block(args):
        xb, e = args
        return (jax.nn.silu(xb @ w1[e]) * (xb @ w3[e])) @ w2[e]

    ys = lax.map(expert_block, (xs, blk_expert)).reshape(P, D)
    out = jnp.zeros((T + 1, D), jnp.float32).at[row_token].add(row_gate[:, None] * ys.astype(jnp.float32))
    return out[:T].reshape(B, S, D).astype(h.dtype)


def setup_inputs(seed: int = 0) -> dict:
    key = jax.random.key(seed)
    ks = jax.random.split(key, 20)
    L, D = DEPTH, D_MODEL
    nrm = lambda k, shape, fan_in: jax.random.normal(k, shape, jnp.float32) * fan_in ** -0.5
    return {
        "x": jax.random.normal(ks[0], (BATCH, SEQ, D), jnp.float32),
        "positions": (jnp.arange(SEQ, dtype=jnp.int32)[None, :]
                      + jax.random.randint(ks[1], (BATCH, 1), 0, 1024, jnp.int32)),
        "attn_norm": 1.0 + 0.1 * jax.random.normal(ks[2], (L, D), jnp.float32),
        "w_in": nrm(ks[3], (L, D, N_IN), D),
        "b_forget": jax.random.uniform(ks[4], (L, FOX_HEADS), jnp.float32, 1.0, 4.0),
        "b_gate": 0.02 * jax.random.normal(ks[5], (L, 2, D), jnp.float32),
        "attn_sinks": jax.random.normal(ks[6], (L, SWA_HEADS), jnp.float32),
        "w_proj_fox": nrm(ks[7], (L, FOX_W, D), FOX_W),
        "w_proj_swa": nrm(ks[8], (L, SWA_W, D), SWA_W),
        "w_out": nrm(ks[9], (L, D, D), D),
        "ffn_norm": 1.0 + 0.1 * jax.random.normal(ks[10], (L, D), jnp.float32),
        "w_group": nrm(ks[11], (L, D, N_GROUPS), D),
        "b_group": 0.01 * jax.random.normal(ks[12], (L, N_GROUPS), jnp.float32),
        "w_expert": nrm(ks[13], (L, D, N_EXPERTS), D),
        "b_expert": 0.01 * jax.random.normal(ks[14], (L, N_EXPERTS), jnp.float32),
        "w1": nrm(ks[15], (L, N_EXPERTS, D, D_EXPERT), D),
        "w3": nrm(ks[16], (L, N_EXPERTS, D, D_EXPERT), D),
        "w2": nrm(ks[17], (L, N_EXPERTS, D_EXPERT, D), D_EXPERT),
        "final_norm": 1.0 + 0.1 * jax.random.normal(ks[18], (D,), jnp.float32),
    }


def reference(x, positions, attn_norm, w_in, b_forget, b_gate, attn_sinks, w_proj_fox, w_proj_swa,
              w_out, ffn_norm, w_group, b_group, w_expert, b_expert, w1, w3, w2, final_norm):
    for l in range(DEPTH):
        h = rms_norm(x, attn_norm[l])
        x = x + hybrid_mixer(h, positions, w_in[l], b_forget[l], b_gate[l], attn_sinks[l],
                             w_proj_fox[l], w_proj_swa[l], w_out[l])
        h = rms_norm(x, ffn_norm[l])
        x = x + hier_moe(h, w_group[l], b_group[l], w_expert[l], b_expert[l], w1[l], w3[l], w2[l])
    return rms_norm(x, final_norm)
```

```cpp
#include <hip/hip_runtime.h>
#include <hip/hip_cooperative_groups.h>
#include <cstdio>
#include <cstdint>
#include <type_traits>
namespace cg = cooperative_groups;

#define LAS __attribute__((address_space(3)))
typedef unsigned short bf16_t;
typedef short bf16x8 __attribute__((ext_vector_type(8)));
typedef short s16x4 __attribute__((ext_vector_type(4)));
typedef float f32x2 __attribute__((ext_vector_type(2)));
typedef float f32x4 __attribute__((ext_vector_type(4)));
typedef float f32x16 __attribute__((ext_vector_type(16)));
typedef unsigned u32x2 __attribute__((ext_vector_type(2)));
typedef unsigned u32x4 __attribute__((ext_vector_type(4)));
typedef int i32x4 __attribute__((ext_vector_type(4)));

constexpr int BATCH = 4, SEQ = 8192, DM = 1024, T = BATCH * SEQ;
constexpr int HD = 64, FOXH = 8, SWAH = 8, SWAKV = 2, WINDOW = 128;
constexpr int NE = 64, DE = 512;
constexpr int N_IN = 4360, NP1 = 4352;
constexpr float EPS = 1e-6f;
constexpr float LOG2E = 1.4426950408889634f;
constexpr float C2 = 0.125f * LOG2E;
constexpr int NWAVES = 8, NTHREADS = 512;

constexpr size_t MiB = 1u << 20;
constexpr size_t WS_CTL = 0, CTL_ZERO_BYTES = 65536, CTL_BAR_OFF = 16384, CTL_NRM_OFF = 32768  , CTL_QUEUE_OFF = 34816  ;
constexpr size_t WS_WIN_T = 1 * MiB;
constexpr size_t WS_WPF_T = 10 * MiB;
constexpr size_t WS_WPS_T = 11 * MiB;
constexpr size_t WS_WOUT_T = 12 * MiB;
constexpr size_t WS_WR = 14 * MiB;
constexpr size_t WS_ROPE = 15 * MiB;
constexpr size_t WS_LOGF = 23 * MiB;
constexpr size_t WS_CUM = 24 * MiB;
constexpr size_t WS_LIST = 25 * MiB;
constexpr size_t WS_GATE = 418 * MiB;
constexpr size_t WS_W13T = 34 * MiB;
constexpr size_t WS_WSC = 9 * MiB + 512 * 1024;
constexpr size_t WS_SAL = 426 * MiB;
constexpr size_t WS_W2T = 162 * MiB;
constexpr size_t WS_R1 = 226 * MiB;
constexpr size_t WS_QF = 290 * MiB, WS_KF = 322 * MiB, WS_VF = 354 * MiB, WS_QS = 386 * MiB, WS_KS = 418 * MiB, WS_VS = 426 * MiB;
constexpr size_t WS_MERGED = 290 * MiB;
constexpr size_t WS_X1B = 354 * MiB;
constexpr size_t WS_YBUF = 226 * MiB;
constexpr size_t WS_END = 434 * MiB;

constexpr int RING_BYTES = 131072;
constexpr int MISC_OFF = RING_BYTES;
constexpr int LDS_BYTES = 147456;

#define LDS_WAIT() asm volatile("s_waitcnt lgkmcnt(0)" ::: "memory")
#define VM_WAIT() asm volatile("s_waitcnt vmcnt(0)" ::: "memory")

__device__ __forceinline__ unsigned f2bf(float f) { unsigned u = __builtin_bit_cast(unsigned, f); return (u + 0x7fffu + ((u >> 16) & 1u)) >> 16; }
__device__ __forceinline__ unsigned pk2(float lo, float hi) { return f2bf(lo) | (f2bf(hi) << 16); }
__device__ __forceinline__ float bf2f(unsigned h) { return __builtin_bit_cast(float, h << 16); }
#define BFLO(w) __builtin_bit_cast(float, (unsigned)(w) << 16)
#define BFHI(w) __builtin_bit_cast(float, (unsigned)(w) & 0xffff0000u)
__device__ __forceinline__ float wave_sum(float v) {
#pragma unroll
    for (int o = 1; o < 64; o <<= 1) v += __shfl_xor(v, o);
    return v;
}
__device__ __forceinline__ float fast_sigmoid(float x) { return __builtin_amdgcn_rcpf(1.0f + __builtin_amdgcn_exp2f(-x * LOG2E)); }

namespace pg8 {
constexpr int BM = 256, BK = 64, HALF = 128, HTB = HALF * BK * 2, STAGE_BYTES = 8 * HTB, NXCD = 8, WGM = 8;
__host__ __device__ __forceinline__ int lds_byte(int r, int c) { const int st = (r >> 4) * 2 + (c >> 5), rr = r & 15, cc = c & 31, ob = rr * 64 + cc * 2; return st * 1024 + (ob ^ (((ob >> 9) & 1) << 5)); }
__host__ __device__ __forceinline__ void stage_rc(int b, int& R, int& C) { const int st = b / 1024, sb = b % 1024, swz = sb ^ (((sb >> 9) & 1) << 5); R = (st >> 1) * 16 + swz / 64; C = (st & 1) * 32 + (swz % 64) / 2; }
__host__ __device__ __forceinline__ int perm32(int rho) { const int n = rho >> 4, i = rho & 15; return 8 * (i >> 2) + 4 * n + (i & 3); }

struct Unit { int pm, pn, e, rows, rowbase, rbg; };

__device__ __forceinline__ bool static_tile(int L, int nM, int nN, int& pm, int& pn) {
    const int nwg = nM * nN; if (L >= nwg) return false;
    int wgid = L; { const int q = nwg / NXCD, r = nwg % NXCD, xcd = wgid % NXCD, off = wgid / NXCD; wgid = (xcd < r ? xcd * (q + 1) : r * (q + 1) + (xcd - r) * q) + off; }
    const int nig = WGM * nN, gid = wgid / nig, fm = gid * WGM, gsz = (nM - fm) < WGM ? (nM - fm) : WGM;
    pm = fm + ((wgid % nig) % gsz); pn = (wgid % nig) / gsz; return true;
}

template <class E, class = void> struct epi_has_mid : std::false_type {};
template <class E> struct epi_has_mid<E, typename std::enable_if<E::HAS_MID>::type> : std::true_type {};
template <class Epi, class Sched>
__device__ __forceinline__ void gemm_phase(LAS unsigned char* lds, const int K, const Sched& S, const Epi& E) {
    const int tid = threadIdx.x, wid = __builtin_amdgcn_readfirstlane(tid >> 6), lane = tid & 63, wr = wid >> 2, wc = wid & 3, fr = lane & 15, fq = lane >> 4;
    constexpr int ES = Sched::ES;
    const int nt = K * ES / (BK * 2);
    unsigned voffB[2]; int RA[2]; unsigned CA2[2];
#pragma unroll
    for (int i = 0; i < 2; ++i) { int R, C; stage_rc(tid * 16 + i * 8192, R, C); const int Rb = (R & ~31) + perm32(R & 31);
        RA[i] = R; CA2[i] = (unsigned)C * 2u; voffB[i] = (unsigned)(Rb * S.ldb * ES) + (unsigned)C * 2u; }
    const size_t kstep = (size_t)(BK * 2);
    const size_t hstepB = (size_t)HALF * S.ldb * ES;
    const unsigned ldsw = (unsigned)wid * 1024u;
    const int aoff = lds_byte(wr * 64 + fr, fq * 8), boff = lds_byte(wc * 32 + fr, fq * 8);
#define PG8_SA(b, h) (((b) * 2 + (h)) * HTB)
#define PG8_SB(b, h) ((4 + (b) * 2 + (h)) * HTB)
#define PG8_STAGE(bufoff, gbase, voff) do { _Pragma("unroll") for (int _i = 0; _i < 2; ++_i) \
        __builtin_amdgcn_global_load_lds((const unsigned*)((const char*)(gbase) + (voff)[_i]), (LAS unsigned*)(lds + (bufoff) + ldsw + _i * 8192), 16, 0, 0); } while (0)
#define PG8_LDA(dst, b, h) do { _Pragma("unroll") for (int m = 0; m < 4; ++m) _Pragma("unroll") for (int k = 0; k < 2; ++k) dst[m][k] = *(const LAS bf16x8*)(lds + PG8_SA(b, h) + aoff + m * 2048 + k * 1024); } while (0)
#define PG8_LDB(dst, b, h) do { _Pragma("unroll") for (int n = 0; n < 2; ++n) _Pragma("unroll") for (int k = 0; k < 2; ++k) dst[n][k] = *(const LAS bf16x8*)(lds + PG8_SB(b, h) + boff + n * 2048 + k * 1024); } while (0)
#define PG8_MMA(ai, bj, At, Bt) do { __builtin_amdgcn_s_setprio(1); _Pragma("unroll") for (int m = 0; m < 4; ++m) _Pragma("unroll") for (int n = 0; n < 2; ++n) _Pragma("unroll") for (int k = 0; k < 2; ++k) { \
        if constexpr (ES == 2) acc[ai][bj][m][n] = __builtin_bit_cast(acc_t, __builtin_amdgcn_mfma_f32_16x16x32_bf16(Bt[n][k], At[m][k], __builtin_bit_cast(f32x4, acc[ai][bj][m][n]), 0, 0, 0)); \
        else acc[ai][bj][m][n] = __builtin_bit_cast(acc_t, __builtin_amdgcn_mfma_i32_16x16x64_i8(__builtin_bit_cast(i32x4, Bt[n][k]), __builtin_bit_cast(i32x4, At[m][k]), __builtin_bit_cast(i32x4, acc[ai][bj][m][n]), 0, 0, 0)); } \
        __builtin_amdgcn_s_setprio(0); } while (0)
#define PG8_WAIT_V(n) asm volatile("s_waitcnt vmcnt(" #n ")" ::: "memory")
#define PG8_WAIT_L(n) asm volatile("s_waitcnt lgkmcnt(" #n ")" ::: "memory")
#define PG8_BAR __builtin_amdgcn_s_barrier()
#define PG8_SCHED __builtin_amdgcn_sched_barrier(0)
    Unit cur, nxt; int ui = 0;
    if (!S.next(0, cur)) return;
    typedef typename Sched::acc_t acc_t;
    acc_t acc[2][2][4][2];
#pragma unroll
    for (int a = 0; a < 2; ++a)
#pragma unroll
        for (int b = 0; b < 2; ++b)
#pragma unroll
            for (int m = 0; m < 4; ++m)
#pragma unroll
                for (int n = 0; n < 2; ++n) acc[a][b][m][n] = acc_t{};
    bf16x8 At[4][2], B0[2][2], B1[2][2];
    const char* cA = S.a_base(cur); const char* cB = S.b_base(cur);
    unsigned offC0[2], offC1[2], offN0[2], offN1[2];
#pragma unroll
    for (int i = 0; i < 2; ++i) { offC0[i] = S.a_off(cur, RA[i]) + CA2[i]; offC1[i] = S.a_off(cur, HALF + RA[i]) + CA2[i]; offN0[i] = offC0[i]; offN1[i] = offC1[i]; }
    PG8_STAGE(PG8_SB(0, 0), cB, voffB); PG8_STAGE(PG8_SB(0, 1), cB + hstepB, voffB); PG8_STAGE(PG8_SA(0, 0), cA, offC0); PG8_STAGE(PG8_SA(0, 1), cA, offC1);
    if (wr == 1) PG8_BAR;
    PG8_WAIT_V(2); PG8_BAR;
    PG8_STAGE(PG8_SB(1, 0), cB + kstep, voffB); PG8_STAGE(PG8_SA(1, 0), cA + kstep, offC0); PG8_STAGE(PG8_SB(1, 1), cB + hstepB + kstep, voffB);
    PG8_WAIT_V(6); PG8_BAR;
    for (;;) {
        const bool has_next = S.next(ui + 1, nxt);
        const char* nA = has_next ? S.a_base(nxt) : cA; const char* nB = has_next ? S.b_base(nxt) : cB;
        if (Sched::GATHER) {
#pragma unroll
            for (int i = 0; i < 2; ++i) { offN0[i] = has_next ? S.a_off(nxt, RA[i]) + CA2[i] : offC0[i]; offN1[i] = has_next ? S.a_off(nxt, HALF + RA[i]) + CA2[i] : offC1[i]; }
        }
        for (int t = 0; t < nt; t += 2) {
            if constexpr (epi_has_mid<Epi>::value) { if (t == (nt >> 1)) E.mid(acc, cur, wr, wc, fr, fq); }
            const bool last = (t == nt - 2);
            const char* a1 = cA + (size_t)(t + 1) * kstep;
            const char* a2 = last ? nA : cA + (size_t)(t + 2) * kstep; const char* b2 = last ? nB : cB + (size_t)(t + 2) * kstep;
            const char* a3 = a2 + kstep; const char* b3 = b2 + kstep;
            unsigned o20[2], o21[2];
#pragma unroll
            for (int i = 0; i < 2; ++i) { o20[i] = (Sched::GATHER && last) ? offN0[i] : offC0[i]; o21[i] = (Sched::GATHER && last) ? offN1[i] : offC1[i]; }
            PG8_LDB(B0, 0, 0); PG8_LDB(B1, 0, 1); PG8_SCHED; PG8_LDA(At, 0, 0); PG8_STAGE(PG8_SA(1, 1), a1, offC1);
            PG8_WAIT_V(8); PG8_WAIT_L(0); PG8_BAR; PG8_MMA(0, 0, At, B0); PG8_MMA(0, 1, At, B1); PG8_BAR; PG8_SCHED;
            PG8_LDA(At, 0, 1); PG8_STAGE(PG8_SB(0, 0), b2, voffB); PG8_STAGE(PG8_SB(0, 1), b2 + hstepB, voffB); PG8_STAGE(PG8_SA(0, 0), a2, o20);
            PG8_WAIT_V(8); PG8_WAIT_L(0); PG8_BAR; PG8_MMA(1, 0, At, B0); PG8_MMA(1, 1, At, B1); PG8_BAR; PG8_SCHED;
            PG8_LDB(B0, 1, 0); PG8_LDB(B1, 1, 1); PG8_SCHED; PG8_LDA(At, 1, 0); PG8_STAGE(PG8_SA(0, 1), a2, o21);
            PG8_WAIT_V(8); PG8_WAIT_L(0); PG8_BAR; PG8_MMA(0, 0, At, B0); PG8_MMA(0, 1, At, B1); PG8_BAR; PG8_SCHED;
            PG8_LDA(At, 1, 1); PG8_STAGE(PG8_SB(1, 0), b3, voffB); PG8_STAGE(PG8_SB(1, 1), b3 + hstepB, voffB); PG8_STAGE(PG8_SA(1, 0), a3, o20);
            PG8_WAIT_V(8); PG8_WAIT_L(0); PG8_BAR; PG8_MMA(1, 0, At, B0); PG8_MMA(1, 1, At, B1); PG8_BAR; PG8_SCHED;
        }
        if (wr == 0) PG8_BAR;
        E(acc, cur, wr, wc, fr, fq);
        if (!has_next) break;
#pragma unroll
        for (int a = 0; a < 2; ++a)
#pragma unroll
            for (int b = 0; b < 2; ++b)
#pragma unroll
                for (int m = 0; m < 4; ++m)
#pragma unroll
                    for (int n = 0; n < 2; ++n) acc[a][b][m][n] = acc_t{};
        cur = nxt; cA = nA; cB = nB; ++ui;
        if (Sched::GATHER) {
#pragma unroll
            for (int i = 0; i < 2; ++i) { offC0[i] = offN0[i]; offC1[i] = offN1[i]; }
        }
        if (wr == 1) PG8_BAR;
    }
    PG8_WAIT_V(0);
    PG8_BAR;
#undef PG8_SA
#undef PG8_SB
#undef PG8_STAGE
#undef PG8_LDA
#undef PG8_LDB
#undef PG8_MMA
#undef PG8_WAIT_V
#undef PG8_WAIT_L
#undef PG8_BAR
#undef PG8_SCHED
}
}
using pg8::Unit;

#include <hip/hip_bf16.h>
namespace attn_body {
using bf16=__hip_bfloat16;
using bf16x8=__attribute__((ext_vector_type(8)))short;
using s16x4=__attribute__((ext_vector_type(4)))short;
using f32x16=__attribute__((ext_vector_type(16)))float;
using u32x4=__attribute__((ext_vector_type(4)))unsigned;
constexpr int BATCH=4,NHEAD=8,SEQ=8192,D=64,DM=NHEAD*D;
constexpr int NW=8,QBLK=32,QB=QBLK*NW,KVBLK=64,NQB=SEQ/QB;
constexpr int ATTN_PITCH=DM, ATTN_UNIT_ROWS=QB;
__device__ __forceinline__ int crow(int r,int hi){return (r&3)+8*(r>>2)+4*hi;}
#define SBAR() __builtin_amdgcn_sched_barrier(0)
__device__ __forceinline__ void cmask(f32x16&p0,f32x16&p1,int jb,int qrel,int hi){
  const float NEG=-INFINITY; int kb=64*jb+4*hi;
  #pragma unroll
  for(int r=0;r<16;++r){int kv=kb+(r&3)+8*(r>>2); if(kv>qrel)p0[r]=NEG; if(kv+32>qrel)p1[r]=NEG;}
}

constexpr int NSLOT=3, SLOTB=8192;
constexpr int LDS_K=0, LDS_V=NSLOT*SLOTB, LDS_WS=2*NSLOT*SLOTB, LDS_OST=LDS_WS+NW*64*4, LDS_CS=LDS_OST+NW*4096, LDS_BYTES=LDS_CS+SEQ*4;
constexpr float C2=0.125f*1.4426950408889634f;
__device__ __forceinline__ void glds16(const void*gsrc,unsigned lds_dst){unsigned keep;
  asm volatile("s_mov_b32 %0, m0\n\ts_mov_b32 m0, %2\n\ts_nop 0\n\tglobal_load_lds_dwordx4 %1, off\n\ts_mov_b32 m0, %0":"=&s"(keep):"v"(gsrc),"s"(lds_dst):"memory");}
__device__ __forceinline__ float max3f(float a,float b,float c){float r;asm("v_max3_f32 %0, %1, %2, %3":"=v"(r):"v"(a),"v"(b),"v"(c));return r;}
__device__ __forceinline__ float max2f(float a,float b){float r;asm("v_max_f32_e32 %0, %1, %2":"=v"(r):"v"(a),"v"(b));return r;}
__device__ __forceinline__ float fadd_s(float a,float b){float r;asm("v_add_f32_e32 %0, %1, %2":"=v"(r):"v"(a),"v"(b));return r;}
__device__ __forceinline__ float fsub_s(float a,float b){float r;asm("v_sub_f32_e32 %0, %1, %2":"=v"(r):"v"(a),"v"(b));return r;}
typedef float f32x2_t __attribute__((ext_vector_type(2))); typedef __bf16 bf16x2_t __attribute__((ext_vector_type(2)));
__device__ __forceinline__ unsigned cvtpk_s(float lo,float hi){f32x2_t v={lo,hi};bf16x2_t b=__builtin_convertvector(v,bf16x2_t);return __builtin_bit_cast(unsigned,b);}
#define WAIT_BAR(N) asm volatile("s_waitcnt vmcnt(" #N ") lgkmcnt(0)\n\ts_barrier":::"memory")

__device__ __forceinline__ void qkt(f32x16&p0,f32x16&p1,const char*Kslot,const bf16x8*qr,const f32x16&c0,const f32x16&c1,int r32,int hi){
  const char*kb=Kslot+hi*1024+r32*16;
  #pragma unroll
  for(int d0=0;d0<4;++d0){
    const bf16x8 b0=*reinterpret_cast<const bf16x8*>(kb+d0*2048);
    const bf16x8 b1=*reinterpret_cast<const bf16x8*>(kb+d0*2048+512);
    if(d0==0){p0=__builtin_amdgcn_mfma_f32_32x32x16_bf16(b0,qr[0],c0,0,0,0);p1=__builtin_amdgcn_mfma_f32_32x32x16_bf16(b1,qr[0],c1,0,0,0);}
    else{p0=__builtin_amdgcn_mfma_f32_32x32x16_bf16(b0,qr[d0],p0,0,0,0);p1=__builtin_amdgcn_mfma_f32_32x32x16_bf16(b1,qr[d0],p1,0,0,0);}}
}
typedef __attribute__((address_space(3))) const char* lds_cptr;
typedef short v4i16_t __attribute__((ext_vector_type(4)));
__device__ __forceinline__ void kload8(bf16x8*kf,lds_cptr kp){
  kf[0]=*(const __attribute__((address_space(3))) bf16x8*)(kp);      kf[1]=*(const __attribute__((address_space(3))) bf16x8*)(kp+512);
  kf[2]=*(const __attribute__((address_space(3))) bf16x8*)(kp+2048); kf[3]=*(const __attribute__((address_space(3))) bf16x8*)(kp+2560);
  kf[4]=*(const __attribute__((address_space(3))) bf16x8*)(kp+4096); kf[5]=*(const __attribute__((address_space(3))) bf16x8*)(kp+4608);
  kf[6]=*(const __attribute__((address_space(3))) bf16x8*)(kp+6144); kf[7]=*(const __attribute__((address_space(3))) bf16x8*)(kp+6656);
}
__device__ __forceinline__ void kload2(bf16x8*kf,lds_cptr kp,int j){ kf[2*j]=*(const __attribute__((address_space(3))) bf16x8*)(kp+j*2048); kf[2*j+1]=*(const __attribute__((address_space(3))) bf16x8*)(kp+j*2048+512); }
__device__ __forceinline__ s16x4 vtr(lds_cptr p){ return __builtin_bit_cast(s16x4,__builtin_amdgcn_ds_read_tr16_b64_v4i16((__attribute__((address_space(3))) v4i16_t*)p)); }
__device__ __forceinline__ float rowmax(const f32x16&p0,const f32x16&p1){
  float a=max3f(p0[0],p0[1],p1[0]),b=max3f(p0[2],p0[3],p1[1]);a=max3f(a,p1[2],p1[3]);
  #pragma unroll
  for(int r=4;r<16;r+=4){a=max3f(a,p0[r],p0[r+1]);b=max3f(b,p0[r+2],p0[r+3]);a=max3f(a,p1[r],p1[r+1]);b=max3f(b,p1[r+2],p1[r+3]);}
  const float m=max2f(a,b);
  auto rr=__builtin_amdgcn_permlane32_swap(__float_as_uint(m),__float_as_uint(m),false,false);
  return max2f(__uint_as_float(rr[0]),__uint_as_float(rr[1]));
}
__device__ __forceinline__ void pv(f32x16*o,int vb,bf16x8 pa0,bf16x8 pa1,bf16x8 pa2,bf16x8 pa3){
  #pragma unroll
  for(int d0=0;d0<2;++d0){s16x4 lo[4],hi[4];
    #pragma unroll
    for(int ks=0;ks<4;++ks){
      asm volatile("ds_read_b64_tr_b16 %0,%1 offset:%c2":"=&v"(lo[ks]):"v"(vb),"i"(d0*4096+ks*1024):"memory");
      asm volatile("ds_read_b64_tr_b16 %0,%1 offset:%c2":"=&v"(hi[ks]):"v"(vb),"i"(d0*4096+ks*1024+512):"memory");}
    asm volatile("s_waitcnt lgkmcnt(0)":::"memory");SBAR();
    #define PK(k) (bf16x8){lo[k][0],lo[k][1],lo[k][2],lo[k][3],hi[k][0],hi[k][1],hi[k][2],hi[k][3]}
    o[d0]=__builtin_amdgcn_mfma_f32_32x32x16_bf16(pa0,PK(0),o[d0],0,0,0);
    o[d0]=__builtin_amdgcn_mfma_f32_32x32x16_bf16(pa1,PK(1),o[d0],0,0,0);
    o[d0]=__builtin_amdgcn_mfma_f32_32x32x16_bf16(pa2,PK(2),o[d0],0,0,0);
    o[d0]=__builtin_amdgcn_mfma_f32_32x32x16_bf16(pa3,PK(3),o[d0],0,0,0);
    #undef PK
  }
}

#ifndef ATTN_STORE16
#define ATTN_STORE16(p,v) (*(u32x4*)(p)=(v))
#endif
template<int THRL> __device__ __forceinline__ void attn_unit(int b,int h,int qb,const bf16*Q,const bf16*__restrict__ K,const bf16*__restrict__ V,bf16*O,const float*__restrict__ cum,const unsigned*__restrict__ nrm,char*shm){
  const int tid=threadIdx.x,lane=tid&63,r32=lane&31,hi=lane>>5; const int wid=__builtin_amdgcn_readfirstlane(tid>>6);
  const long rowbase=(long)b*SEQ; const int q0=qb*QB;
  const bf16*Qw=Q+(rowbase+q0+wid*QBLK)*DM+h*D;
  const float*crow_=cum+(long)b*NHEAD*SEQ+(long)h*SEQ;
  int jst;
  { const int bh2=(b*NHEAD+h)*2;
    const float qs=__uint_as_float(nrm[bh2])+__uint_as_float(nrm[bh2+1]), ks=__uint_as_float(nrm[128+bh2])+__uint_as_float(nrm[128+bh2+1]);
    const float Tthr=160.0f+2.04f*__builtin_sqrtf(qs*ks);
    const float cq0=crow_[q0]; const int NTF=(q0+QB)/KVBLK; const int j1=lane+1,j2=lane+65;
    const bool c1=(j1<=NTF-4)&&(cq0-crow_[64*(j1<=NTF-4?j1:1)-1]<-Tthr), c2=(j2<=NTF-4)&&(cq0-crow_[64*(j2<=NTF-4?j2:1)-1]<-Tthr);
    jst=__builtin_amdgcn_readfirstlane((__popcll(__ballot(c1))+__popcll(__ballot(c2)))&~1); }
  const bf16*Kh=K+(rowbase+(long)jst*KVBLK)*DM+h*D,*Vh=V+(rowbase+(long)jst*KVBLK)*DM+h*D;
  const unsigned lds0=(unsigned)(uintptr_t)shm;
  float*wsf=(float*)(shm+LDS_WS)+wid*64;
  const bf16*ksrc=Kh+(long)lane*DM+wid*8;
  const bf16*vsrc=Vh+(long)(16*(wid&3)+(lane>>2))*DM+(wid>>2)*32+(lane&3)*8;
  const unsigned kdst=lds0+LDS_K+wid*1024, vdst=lds0+LDS_V+wid*1024;
  #define DMA_K(t,slot) glds16(ksrc+(long)(t)*KVBLK*DM,(unsigned)__builtin_amdgcn_readfirstlane(kdst+(slot)))
  #define DMA_V(t,slot) glds16(vsrc+(long)(t)*KVBLK*DM,(unsigned)__builtin_amdgcn_readfirstlane(vdst+(slot)))
  const int vb0=(int)(lds0+LDS_V)+((lane>>4)&1)*32+(lane&3)*8+(4*hi+((lane&15)>>2))*64;
  const char*Kbase=shm+LDS_K; bf16x8 kf[8];
  const lds_cptr shm3=(lds_cptr)shm; const lds_cptr kp0=shm3+LDS_K+hi*1024+r32*16; const lds_cptr vp0=shm3+LDS_V+((lane>>4)&1)*32+(lane&3)*8+(4*hi+((lane&15)>>2))*64;
  const int NT=(q0+QB)/KVBLK-jst;
  { for(int p=(jst>>2)+wid;p<=qb;p+=NW) glds16(crow_+p*256+lane*4,(unsigned)__builtin_amdgcn_readfirstlane(lds0+LDS_CS+p*1024)); }
  const float ctq=crow_[q0+wid*QBLK+r32];
  const float*csl=(const float*)(shm+LDS_CS)+jst*KVBLK;
  DMA_K(0,0);DMA_V(0,0);DMA_K(1,SLOTB);
  bf16x8 qr[4];
  #pragma unroll
  for(int d0=0;d0<4;++d0)qr[d0]=*reinterpret_cast<const bf16x8*>(&Qw[(long)r32*DM+d0*16+hi*8]);
  float l_reg=0.f;f32x16 o[2];o[0]=f32x16{};o[1]=f32x16{};const f32x16 zero16=f32x16{};
  float bq=hi?ctq:-1.0f;
  #define BQ_UPDATE(dl_) do{ bq=hi?(bq-(dl_)):-1.0f; }while(0)
  #define BIAS(C0,C1,t) do{ const float a0_=hi?1.0f:csl[(t)*64+r32]; const float a1_=hi?1.0f:csl[(t)*64+32+r32]; \
      C0=__builtin_amdgcn_mfma_f32_32x32x2f32(a0_,bq,zero16,0,0,0); C1=__builtin_amdgcn_mfma_f32_32x32x2f32(a1_,bq,zero16,0,0,0); }while(0)
  const int qrel=wid*QBLK+r32;
  #define CMASK(P0,P1,t) do{int jb_=(t)-(NT-4); if(jb_>=0)cmask(P0,P1,jb_,qrel,hi);}while(0)
  bool resc=false;
  #define START(P0,P1) do{ const float rm=rowmax(P0,P1); resc=false; \
    { const float dl=rm; \
      _Pragma("unroll") for(int r=0;r<16;++r){P0[r]=fsub_s(P0[r],dl);P1[r]=fsub_s(P1[r],dl);} \
      BQ_UPDATE(dl); } \
    _Pragma("unroll") for(int r=0;r<16;++r)P0[r]=__builtin_amdgcn_exp2f(P0[r]); }while(0)
  #define RESC() do{ if(resc){ asm volatile("s_waitcnt lgkmcnt(0)":::"memory"); \
      _Pragma("unroll") for(int d_=0;d_<2;++d_) _Pragma("unroll") for(int r=0;r<16;++r)o[d_][r]*=wsf[crow(r,hi)]; } }while(0)
  f32x16 pA0,pA1,pB0,pB1;
  int sl_prev=0,sl_cur=0,sl_next=SLOTB;
  #define ROT() do{sl_prev=sl_cur;sl_cur=sl_next;sl_next=(sl_next==(NSLOT-1)*SLOTB)?0:sl_next+SLOTB;}while(0)
  DMA_K(2,2*SLOTB);
  WAIT_BAR(3);
  { f32x16 cb0,cb1; BIAS(cb0,cb1,0); qkt(pA0,pA1,Kbase,qr,cb0,cb1,r32,hi); } asm volatile("s_nop 15\n\ts_nop 7":"+v"(pA0),"+v"(pA1));CMASK(pA0,pA1,0);
  START(pA0,pA1);
  _Pragma("unroll") for(int r=0;r<16;++r)pA1[r]=__builtin_amdgcn_exp2f(pA1[r]);
  WAIT_BAR(0);
  DMA_K(3,0);DMA_V(1,SLOTB);
  ROT();
  kload8(kf,kp0+sl_cur);
  WAIT_BAR(2);
  s16x4 vlo[8],vhi[8]; u32x4 pw0,pw1,pw2,pw3;
  #define PKW(P,B) cvtpk_s(P[B],P[B+1])
  #define PAF(k) __builtin_bit_cast(bf16x8,pw##k)
  #define VFR(i) (bf16x8){vlo[i][0],vlo[i][1],vlo[i][2],vlo[i][3],vhi[i][0],vhi[i][1],vhi[i][2],vhi[i][3]}
  #define PIN(x) asm volatile("":"+v"(x))
  #define MX3(a,b,c) __builtin_fmaxf(__builtin_fmaxf((a),(b)),(c))
  #define GAPA(MF,A0,A1,A2,A3,W0,W1,PW) do{ MF; sacc+=A0; sacc+=A1; sacc+=A2; sacc+=A3; PIN(sacc); W0; W1; PIN(PW); SBAR(); }while(0)
  #define EX(v) __builtin_amdgcn_exp2f(v)
  #define GAPB(MF,X,B) do{ MF; X[B]=EX(X[B]); X[B+1]=EX(X[B+1]); X[B+2]=EX(X[B+2]); X[B+3]=EX(X[B+3]); PIN(X); SBAR(); }while(0)
  #define VRD(i) do{ vlo[i]=vtr(vp_+(((i)>>2)*4096+((i)&3)*1024)); vhi[i]=vtr(vp_+(((i)>>2)*4096+((i)&3)*1024+512)); }while(0)
  #define KRD(G,j) do{ if(G){ kload2(kf,kp0+sl_next,j); SBAR(); } }while(0)
  #define STEP(C0,C1,P0,P1,t,GK,GV,GL) do{ SBAR(); \
    BIAS(C0,C1,t); SBAR(); \
    const lds_cptr vp_=vp0+sl_prev; \
    VRD(0); SBAR(); float sacc=(P0[0]+P0[1]); \
    GAPA(C0=__builtin_amdgcn_mfma_f32_32x32x16_bf16(kf[0],qr[0],C0,0,0,0), P0[2],P0[3],P0[4],P0[5],     pw0[0]=PKW(P0,0), pw0[1]=PKW(P0,2), pw0); \
    VRD(4); SBAR(); GAPA(C1=__builtin_amdgcn_mfma_f32_32x32x16_bf16(kf[1],qr[0],C1,0,0,0), P0[6],P0[7],P0[8],P0[9],     pw0[2]=PKW(P0,4), pw0[3]=PKW(P0,6), pw0); \
    VRD(1); SBAR(); GAPA(C0=__builtin_amdgcn_mfma_f32_32x32x16_bf16(kf[2],qr[1],C0,0,0,0),   P0[10],P0[11],P0[12],P0[13], pw1[0]=PKW(P0,8), pw1[1]=PKW(P0,10), pw1); \
    VRD(5); SBAR(); GAPA(C1=__builtin_amdgcn_mfma_f32_32x32x16_bf16(kf[3],qr[1],C1,0,0,0),   P0[14],P0[15],P1[0],P1[1],   pw1[2]=PKW(P0,12),pw1[3]=PKW(P0,14), pw1); \
    VRD(2); SBAR(); GAPA(C0=__builtin_amdgcn_mfma_f32_32x32x16_bf16(kf[4],qr[2],C0,0,0,0),   P1[2],P1[3],P1[4],P1[5],     pw2[0]=PKW(P1,0), pw2[1]=PKW(P1,2), pw2); \
    VRD(6); SBAR(); GAPA(C1=__builtin_amdgcn_mfma_f32_32x32x16_bf16(kf[5],qr[2],C1,0,0,0),   P1[6],P1[7],P1[8],P1[9],     pw2[2]=PKW(P1,4), pw2[3]=PKW(P1,6), pw2); \
    VRD(3); SBAR(); GAPA(C0=__builtin_amdgcn_mfma_f32_32x32x16_bf16(kf[6],qr[3],C0,0,0,0),   P1[10],P1[11],P1[12],P1[13], pw3[0]=PKW(P1,8), pw3[1]=PKW(P1,10), pw3); \
    VRD(7); SBAR(); GAPA(C1=__builtin_amdgcn_mfma_f32_32x32x16_bf16(kf[7],qr[3],C1,0,0,0),   P1[14],P1[15],0.f,0.f,       pw3[2]=PKW(P1,12),pw3[3]=PKW(P1,14), pw3); \
    l_reg+=sacc; \
    if(GK){DMA_K((t)+3,sl_cur);} if(GV){DMA_V((t)+1,sl_next);} \
    CMASK(C0,C1,t); \
    { float a=MX3(C0[0],C0[1],C1[0]),b=MX3(C0[2],C0[3],C1[1]); a=MX3(a,C1[2],C1[3]); \
      _Pragma("unroll") for(int r=4;r<16;r+=4){a=MX3(a,C0[r],C0[r+1]);b=MX3(b,C0[r+2],C0[r+3]);a=MX3(a,C1[r],C1[r+1]);b=MX3(b,C1[r+2],C1[r+3]);} \
      float rm=__builtin_fmaxf(a,b); { auto rr=__builtin_amdgcn_permlane32_swap(__float_as_uint(rm),__float_as_uint(rm),false,false); rm=__builtin_fmaxf(__uint_as_float(rr[0]),__uint_as_float(rr[1])); } \
      resc=false; \
      if(__builtin_expect(__any(rm>(float)THRL),0)){ const float dl=__builtin_fmaxf(rm,0.f); \
        _Pragma("unroll") for(int r=0;r<16;++r){C0[r]-=dl;C1[r]-=dl;} \
        BQ_UPDATE(dl); \
        const float f=__builtin_amdgcn_exp2f(-dl); l_reg*=f; if(hi==0)wsf[r32]=f; resc=true; } } \
    SBAR(); \
    GAPB(o[0]=__builtin_amdgcn_mfma_f32_32x32x16_bf16(PAF(0),VFR(0),o[0],0,0,0), C0,0); \
    GAPB(o[1]=__builtin_amdgcn_mfma_f32_32x32x16_bf16(PAF(0),VFR(4),o[1],0,0,0), C0,4); \
    KRD(GL,0); GAPB(o[0]=__builtin_amdgcn_mfma_f32_32x32x16_bf16(PAF(1),VFR(1),o[0],0,0,0), C0,8); \
    KRD(GL,1); GAPB(o[1]=__builtin_amdgcn_mfma_f32_32x32x16_bf16(PAF(1),VFR(5),o[1],0,0,0), C0,12); \
    KRD(GL,2); GAPB(o[0]=__builtin_amdgcn_mfma_f32_32x32x16_bf16(PAF(2),VFR(2),o[0],0,0,0), C1,0); \
    KRD(GL,3); GAPB(o[1]=__builtin_amdgcn_mfma_f32_32x32x16_bf16(PAF(2),VFR(6),o[1],0,0,0), C1,4); \
    GAPB(o[0]=__builtin_amdgcn_mfma_f32_32x32x16_bf16(PAF(3),VFR(3),o[0],0,0,0), C1,8); \
    GAPB(o[1]=__builtin_amdgcn_mfma_f32_32x32x16_bf16(PAF(3),VFR(7),o[1],0,0,0), C1,12); \
    }while(0)
  int t=1;
  #undef CMASK
  #define CMASK(P0,P1,t) do{}while(0)
  for(;t+5<NT;t+=2){
    STEP(pB0,pB1,pA0,pA1,t,true,true,true);     WAIT_BAR(2); RESC(); ROT();
    STEP(pA0,pA1,pB0,pB1,t+1,true,true,true);   WAIT_BAR(2); RESC(); ROT();
  }
  #undef CMASK
  #define CMASK(P0,P1,t) do{int jb_=(t)-(NT-4); if(jb_>=0)cmask(P0,P1,jb_,qrel,hi);}while(0)
  #define ENDW(tt) do{ if((tt)+3<NT){WAIT_BAR(2);} else if((tt)+2<NT){WAIT_BAR(1);} else {WAIT_BAR(0);} }while(0)
  for(;t+1<NT;t+=2){
    STEP(pB0,pB1,pA0,pA1,t,(t+3<NT),(t+1<NT),(t+1<NT));       ENDW(t);   RESC(); ROT();
    STEP(pA0,pA1,pB0,pB1,t+1,(t+4<NT),(t+2<NT),(t+2<NT));     ENDW(t+1); RESC(); ROT();
  }
  STEP(pB0,pB1,pA0,pA1,NT-1,false,false,false); RESC();
  { float sacc=pB0[0]+pB0[1]; _Pragma("unroll") for(int r=2;r<16;++r)sacc+=pB0[r]; _Pragma("unroll") for(int r=0;r<16;++r)sacc+=pB1[r]; l_reg+=sacc;
    pw0=(u32x4){PKW(pB0,0),PKW(pB0,2),PKW(pB0,4),PKW(pB0,6)};pw1=(u32x4){PKW(pB0,8),PKW(pB0,10),PKW(pB0,12),PKW(pB0,14)};pw2=(u32x4){PKW(pB1,0),PKW(pB1,2),PKW(pB1,4),PKW(pB1,6)};pw3=(u32x4){PKW(pB1,8),PKW(pB1,10),PKW(pB1,12),PKW(pB1,14)};
    SBAR(); pv(o,vb0+sl_cur,PAF(0),PAF(1),PAF(2),PAF(3)); }
  #undef PKW
  #undef PAF
  #undef VFR
  #undef PIN
  #undef MX3
  #undef GAPA
  #undef GAPB
  #undef EX
  #undef VRD
  #undef KRD
  #undef STEP
  #undef ENDW
  {auto rr=__builtin_amdgcn_permlane32_swap(__float_as_uint(l_reg),__float_as_uint(l_reg),false,false);l_reg=__uint_as_float(rr[0])+__uint_as_float(rr[1]);}
  if(hi==0)wsf[32+r32]=l_reg;asm volatile("s_waitcnt lgkmcnt(0)":::"memory");
  float rli[16];
  #pragma unroll
  for(int r=0;r<16;++r)rli[r]=__builtin_amdgcn_rcpf(wsf[32+crow(r,hi)]);
  constexpr int OPITCH=2*DM;
  bf16*Ow=O+(rowbase+q0+wid*QBLK)*OPITCH+h*D;
  { bf16*stg=(bf16*)(shm+LDS_OST)+wid*2048;
    #pragma unroll
    for(int r=0;r<16;++r){const int orow=crow(r,hi);
      #pragma unroll
      for(int d0=0;d0<2;++d0)stg[orow*64+d0*32+r32]=__float2bfloat16(o[d0][r]*rli[r]);}
    asm volatile("s_waitcnt lgkmcnt(0)":::"memory");
    #pragma unroll
    for(int i=0;i<4;++i){const int row=i*8+(lane>>3),ch=lane&7; const u32x4 v=*(const u32x4*)(stg+row*64+ch*8); ATTN_STORE16(Ow+(long)row*OPITCH+ch*8,v);} }
  asm volatile("s_waitcnt lgkmcnt(0)\n\ts_barrier":::"memory");
  #undef DMA_K
  #undef DMA_V
  #undef CMASK
  #undef START
  #undef RESC
  #undef ROT
  #undef BIAS
  #undef BQ_UPDATE
}
constexpr int ATTN_LDS_BYTES=LDS_BYTES;
struct AttnTensors { const bf16* Q; const bf16* K; const bf16* V; bf16* O; const float* cum; };
struct AttnUnit { int bh; int qb; };
struct StaticOrder {
  int vcu;
  __device__ __forceinline__ explicit StaticOrder(int grid,int block):vcu((block%8)*(grid/8)+block/8){}
  __device__ __forceinline__ bool next(int i,AttnUnit&u)const{ if(i>=4)return false; const int s=vcu&7; u.bh=vcu>>3; u.qb=(i==0)?s:(i==1)?15-s:(i==2)?16+s:31-s; return true; }
  __device__ __forceinline__ void a_ready(const AttnUnit&)const{}
  __device__ __forceinline__ void done(const AttnUnit&)const{}
};
template<class Sched,int THRL=8> __device__ __forceinline__ void attn_phase(char*lds,const AttnTensors&T,const Sched&S){
  AttnUnit u;
  for(int i=0;S.next(i,u);++i){ S.a_ready(u); attn_unit<THRL>(u.bh/NHEAD,u.bh%NHEAD,u.qb,T.Q,T.K,T.V,T.O,T.cum,lds); S.done(u); }
}
#undef SBAR
#undef WAIT_BAR
}

__device__ __forceinline__ unsigned cvt_pk_bf16(float lo, float hi) {
    typedef __bf16 bf16x2_t __attribute__((ext_vector_type(2)));
    f32x2 v = {lo, hi}; bf16x2_t b = __builtin_convertvector(v, bf16x2_t); return __builtin_bit_cast(unsigned, b);
}
__device__ __forceinline__ u32x4 pack8(const f32x4 a, const f32x4 b) { u32x4 w; w.x = cvt_pk_bf16(a[0], a[1]); w.y = cvt_pk_bf16(a[2], a[3]); w.z = cvt_pk_bf16(b[0], b[1]); w.w = cvt_pk_bf16(b[2], b[3]); return w; }
__device__ __forceinline__ u32x2 pack4(const f32x4 a) { u32x2 w; w.x = cvt_pk_bf16(a[0], a[1]); w.y = cvt_pk_bf16(a[2], a[3]); return w; }

struct SchedDense {
    static constexpr bool GATHER = false; static constexpr int ES = 2; typedef f32x4 acc_t;
    const char* A; const char* B; int lda, ldb, nM, nN, G, c;
    __device__ __forceinline__ bool next(int i, Unit& u) const { u.e = 0; u.rows = 256; u.rowbase = 0; u.rbg = 0; return pg8::static_tile(i * G + c, nM, nN, u.pm, u.pn); }
    __device__ __forceinline__ const char* a_base(const Unit& u) const { return A + (size_t)u.pm * 256 * lda * 2; }
    __device__ __forceinline__ const char* b_base(const Unit& u) const { return B + (size_t)u.pn * 256 * ldb * 2; }
    __device__ __forceinline__ unsigned a_off(const Unit&, int R) const { return (unsigned)(R * lda) * 2u; }
};
struct SchedProj {
    static constexpr bool GATHER = false; static constexpr int ES = 2; typedef f32x4 acc_t;
    const char* A0; const char* B0; size_t dA, dB; int lda, ldb, nM, nN, G, c;
    __device__ __forceinline__ bool next(int i, Unit& u) const { u.e = i & 1; u.rows = 256; u.rowbase = 0; u.rbg = 0; return pg8::static_tile((i >> 1) * G + c, nM, nN, u.pm, u.pn); }
    __device__ __forceinline__ const char* a_base(const Unit& u) const { return A0 + (size_t)u.e * dA + (size_t)u.pm * 256 * lda * 2; }
    __device__ __forceinline__ const char* b_base(const Unit& u) const { return B0 + (size_t)u.e * dB + (size_t)u.pn * 256 * ldb * 2; }
    __device__ __forceinline__ unsigned a_off(const Unit&, int R) const { return (unsigned)(R * lda) * 2u; }
};
struct MoeTab { const LAS int* pre; const LAS int* cnt; };
__device__ __forceinline__ bool moe_unit(const MoeTab& tb, int L, Unit& u) {
    const int nrb = tb.pre[NE];
    if (L >= nrb * 4) return false;
    const int rbg = L >> 2; u.pn = L & 3; u.rbg = rbg;
    int lo = 0, hi = NE - 1;
#pragma unroll 1
    while (lo < hi) { const int mid = (lo + hi + 1) >> 1; if (tb.pre[mid] <= rbg) lo = mid; else hi = mid - 1; }
#pragma unroll 1
    while (tb.pre[lo + 1] <= rbg) ++lo;
    const int rb = rbg - tb.pre[lo];
    u.e = lo; u.pm = rb; const int left = tb.cnt[lo] - rb * 256; u.rows = left < 256 ? left : 256; u.rowbase = lo * T + rb * 256;
    return true;
}
struct SchedMoe1 {
    static constexpr bool GATHER = true; static constexpr int ES = 1; typedef i32x4 acc_t;
    const char* A; const char* B; const int* list; int lda, ldb, G, v; MoeTab tb;
    __device__ __forceinline__ bool next(int i, Unit& u) const { return moe_unit(tb, i * G + v, u); }
    __device__ __forceinline__ const char* a_base(const Unit&) const { return A; }
    __device__ __forceinline__ const char* b_base(const Unit& u) const { return B + ((size_t)u.e * 1024 + (size_t)u.pn * 256) * ldb; }
    __device__ __forceinline__ unsigned a_off(const Unit& u, int R) const { const int id = (R < u.rows) ? list[u.rowbase + R] : 0; return (unsigned)(id >> 1) * (unsigned)lda; }
};
struct SchedMoe2 {
    static constexpr int ES = 2; typedef f32x4 acc_t;
    static constexpr bool GATHER = true;
    const char* A; const char* B; int lda, ldb, G, v; MoeTab tb;
    __device__ __forceinline__ bool next(int i, Unit& u) const { return moe_unit(tb, i * G + v, u); }
    __device__ __forceinline__ const char* a_base(const Unit& u) const { return A + (size_t)u.rbg * 256 * lda * 2; }
    __device__ __forceinline__ const char* b_base(const Unit& u) const { return B + ((size_t)u.e * 1024 + (size_t)u.pn * 256) * ldb * 2; }
    __device__ __forceinline__ unsigned a_off(const Unit&, int R) const { return (unsigned)(R * lda) * 2u; }
};

struct EpiInProj {
    unsigned char* ws; unsigned char* G; const float* rope; const float* bgate; unsigned* nrm;
    __device__ __forceinline__ void operator()(const f32x4 (&acc)[2][2][4][2], const Unit& u, int wr, int wc, int fr, int fq) const {
        const int pn = u.pn;
        const int row0 = u.pm * 256 + wr * 64 + fr;
#pragma unroll
        for (int bj = 0; bj < 2; ++bj) {
            const int c8 = pn * 256 + bj * 128 + wc * 32 + fq * 8;
            if (pn < 6) {
                bf16_t* base = (bf16_t*)(ws + WS_QF + (size_t)(pn >> 1) * (WS_KF - WS_QF)); const int col = c8 & 511; const float sc = pn < 2 ? C2 : 1.0f;
                float mx = 0.f;
#pragma unroll
                for (int ai = 0; ai < 2; ++ai)
#pragma unroll
                    for (int m = 0; m < 4; ++m) { const int row = row0 + ai * 128 + m * 16;
                        const f32x4 v0 = acc[ai][bj][m][0] * sc, v1 = acc[ai][bj][m][1] * sc;
                        *(u32x4*)(base + (size_t)row * 512 + col) = pack8(v0, v1);
                        if (pn < 4) { float ss = (v0[0] * v0[0] + v0[1] * v0[1]) + (v0[2] * v0[2] + v0[3] * v0[3]) + (v1[0] * v1[0] + v1[1] * v1[1]) + (v1[2] * v1[2] + v1[3] * v1[3]);
                            ss += __shfl_xor(ss, 16); ss += __shfl_xor(ss, 32); mx = fmaxf(mx, ss); } }
                if (pn < 4) {
#pragma unroll
                    for (int o = 1; o < 16; o <<= 1) mx = fmaxf(mx, __shfl_xor(mx, o));
                    const int hd = (pn & 1) * 4 + bj * 2 + (wc >> 1), bb = u.pm >> 5;
                    if (fr == 0 && fq == 0) atomicMax(nrm + (pn >> 1) * 128 + (bb * 8 + hd) * 2 + (wc & 1), __float_as_uint(mx)); }
            } else if (pn < 8 || (pn == 8 && bj == 0)) {
                const bool isq = pn < 8; const int cc = c8 - (isq ? 1536 : 2048); const int hd = cc >> 6, d0 = (cc & 63) >> 1;
                bf16_t* base = (bf16_t*)(ws + (isq ? WS_QS : WS_KS)); const int ld = isq ? 512 : 128; const float sc = isq ? C2 : 1.0f;
#pragma unroll
                for (int ai = 0; ai < 2; ++ai) {
                    f32x4 csv[4], snv[4];
#pragma unroll
                    for (int m = 0; m < 4; ++m) { const int row = row0 + ai * 128 + m * 16; csv[m] = *(const f32x4*)(rope + (size_t)row * 64 + d0); snv[m] = *(const f32x4*)(rope + (size_t)row * 64 + 32 + d0); }
                    asm volatile("" ::: "memory");
#pragma unroll
                    for (int m = 0; m < 4; ++m) { const int row = row0 + ai * 128 + m * 16;
                        const f32x4 x1 = acc[ai][bj][m][0], x2 = acc[ai][bj][m][1];
                        const f32x4 lo = (x1 * csv[m] - x2 * snv[m]) * sc, hi = (x2 * csv[m] + x1 * snv[m]) * sc;
                        bf16_t* p = base + (size_t)row * ld + hd * 64 + d0;
                        *(u32x2*)p = pack4(lo); *(u32x2*)(p + 32) = pack4(hi); }
                    asm volatile("" ::: "memory"); }
            } else if (pn == 8) {
                const int col = c8 - 2176;
#pragma unroll
                for (int ai = 0; ai < 2; ++ai)
#pragma unroll
                    for (int m = 0; m < 4; ++m) { const int row = row0 + ai * 128 + m * 16;
                        *(u32x4*)((bf16_t*)(ws + WS_VS) + (size_t)row * 128 + col) = pack8(acc[ai][bj][m][0], acc[ai][bj][m][1]); }
            } else {
                const int j = c8 - 2304;
                const f32x4 b0 = *(const f32x4*)(bgate + j), b1 = *(const f32x4*)(bgate + j + 4);
#pragma unroll
                for (int ai = 0; ai < 2; ++ai)
#pragma unroll
                    for (int m = 0; m < 4; ++m) { const int row = row0 + ai * 128 + m * 16;
                        f32x4 v0 = acc[ai][bj][m][0] + b0, v1 = acc[ai][bj][m][1] + b1;
                        unsigned lo8 = 0u, hi8 = 0u; const unsigned qmin = (j >= 1024) ? 1u : 0u;
#pragma unroll
                        for (int q = 0; q < 4; ++q) { unsigned a_ = (unsigned)(fast_sigmoid(v0[q]) * 255.0f + 0.5f), b_ = (unsigned)(fast_sigmoid(v1[q]) * 255.0f + 0.5f); a_ = a_ < qmin ? qmin : a_; b_ = b_ < qmin ? qmin : b_; lo8 |= a_ << (8 * q); hi8 |= b_ << (8 * q); }
                        u32x2 w; w.x = lo8; w.y = hi8; *(u32x2*)(G + (size_t)row * 2048 + j) = w; }
            }
        }
    }
};
struct EpiProjF {
    static constexpr bool HAS_MID = true;
    bf16_t* __restrict__ M; const unsigned char* __restrict__ G;
    __device__ __forceinline__ void mid(f32x4 (&acc)[2][2][4][2], const Unit& u, int wr, int wc, int fr, int fq) const {
        unsigned base = (unsigned)(u.pm * 256 + wr * 64 + fr) * 2048u + (unsigned)(u.pn * 256 + wc * 32 + fq * 8);
        asm volatile("" : "+v"(base));
#pragma unroll
        for (int ai = 0; ai < 2; ++ai)
#pragma unroll
            for (int mh = 0; mh < 2; ++mh) {
                u32x2 gf[2][2], gs[2][2];
#pragma unroll
                for (int m2 = 0; m2 < 2; ++m2)
#pragma unroll
                    for (int bj = 0; bj < 2; ++bj) { const unsigned off = base + (unsigned)((ai * 128 + (mh * 2 + m2) * 16) * 2048 + bj * 128); gf[m2][bj] = *(const u32x2*)(G + off); gs[m2][bj] = *(const u32x2*)(G + off + 1024u); }
                asm volatile("" ::: "memory");
#pragma unroll
                for (int m2 = 0; m2 < 2; ++m2)
#pragma unroll
                    for (int bj = 0; bj < 2; ++bj) { const u32x2 a = gf[m2][bj], b = gs[m2][bj]; const int m = mh * 2 + m2;
#define RAT(x, y, sh) ((float)(((x) >> (sh)) & 0xffu) * __builtin_amdgcn_rcpf((float)(((y) >> (sh)) & 0xffu)))
                        acc[ai][bj][m][0][0] *= RAT(a.x, b.x, 0); acc[ai][bj][m][0][1] *= RAT(a.x, b.x, 8); acc[ai][bj][m][0][2] *= RAT(a.x, b.x, 16); acc[ai][bj][m][0][3] *= RAT(a.x, b.x, 24);
                        acc[ai][bj][m][1][0] *= RAT(a.y, b.y, 0); acc[ai][bj][m][1][1] *= RAT(a.y, b.y, 8); acc[ai][bj][m][1][2] *= RAT(a.y, b.y, 16); acc[ai][bj][m][1][3] *= RAT(a.y, b.y, 24);
#undef RAT
                    }
                asm volatile("" ::: "memory");
            }
    }
    __device__ __forceinline__ void operator()(const f32x4 (&acc)[2][2][4][2], const Unit& u, int wr, int wc, int fr, int fq) const {
        unsigned rowc = (unsigned)(u.pm * 256 + wr * 64 + fr) * 1024u + (unsigned)(u.pn * 256 + wc * 32 + fq * 8);
        asm volatile("" : "+v"(rowc));
        const unsigned colp = (unsigned)(u.pn * 256 + wc * 32 + fq * 8);
        constexpr float I255 = 1.0f / 255.0f;
#pragma unroll
        for (int ai = 0; ai < 2; ++ai) {
            u32x2 gw[4][2];
#pragma unroll
            for (int m = 0; m < 4; ++m)
#pragma unroll
                for (int bj = 0; bj < 2; ++bj) { const unsigned mo = rowc + (unsigned)((ai * 128 + m * 16) * 1024 + bj * 128); gw[m][bj] = *(const u32x2*)(G + (2u * mo - colp - (unsigned)(bj * 128)) + 1024u); }
            asm volatile("" ::: "memory");
#pragma unroll
            for (int m = 0; m < 4; ++m)
#pragma unroll
                for (int bj = 0; bj < 2; ++bj) { const unsigned mo = rowc + (unsigned)((ai * 128 + m * 16) * 1024 + bj * 128);
                    const u32x2 g = gw[m][bj]; f32x4 v0 = acc[ai][bj][m][0], v1 = acc[ai][bj][m][1];
                    v0[0] *= (float)(g.x & 0xffu) * I255; v0[1] *= (float)((g.x >> 8) & 0xffu) * I255; v0[2] *= (float)((g.x >> 16) & 0xffu) * I255; v0[3] *= (float)(g.x >> 24) * I255;
                    v1[0] *= (float)(g.y & 0xffu) * I255; v1[1] *= (float)((g.y >> 8) & 0xffu) * I255; v1[2] *= (float)((g.y >> 16) & 0xffu) * I255; v1[3] *= (float)(g.y >> 24) * I255;
                    *(u32x4*)(M + mo) = pack8(v0, v1); }
            asm volatile("" ::: "memory");
        }
    }
};
struct EpiOut {
    const float* __restrict__ X; bf16_t* __restrict__ O;
    __device__ __forceinline__ void operator()(const f32x4 (&acc)[2][2][4][2], const Unit& u, int wr, int wc, int fr, int fq) const {
        const int row0 = u.pm * 256 + wr * 64 + fr; const int col0 = u.pn * 256 + wc * 32 + fq * 8;
#pragma unroll
        for (int ai = 0; ai < 2; ++ai) {
            f32x4 xa[4][2][2];
#pragma unroll
            for (int m = 0; m < 4; ++m)
#pragma unroll
                for (int bj = 0; bj < 2; ++bj) { const size_t off = (size_t)(row0 + ai * 128 + m * 16) * 1024 + col0 + bj * 128;
                    xa[m][bj][0] = *(const f32x4*)(X + off); xa[m][bj][1] = *(const f32x4*)(X + off + 4); }
            asm volatile("" ::: "memory");
#pragma unroll
            for (int m = 0; m < 4; ++m)
#pragma unroll
                for (int bj = 0; bj < 2; ++bj) { const size_t off = (size_t)(row0 + ai * 128 + m * 16) * 1024 + col0 + bj * 128;
                    *(u32x4*)(O + off) = pack8(xa[m][bj][0] + acc[ai][bj][m][0], xa[m][bj][1] + acc[ai][bj][m][1]); }
            asm volatile("" ::: "memory");
        }
    }
};
struct EpiMoe1 {
    bf16_t* __restrict__ H; const float* __restrict__ saL; const float* __restrict__ wsc;
    __device__ __forceinline__ void operator()(const i32x4 (&acc)[2][2][4][2], const Unit& u, int wr, int wc, int fr, int fq) const {
        const int row0 = u.rbg * 256 + wr * 64 + fr;
        float sr[2][4];
#pragma unroll
        for (int ai = 0; ai < 2; ++ai)
#pragma unroll
            for (int m = 0; m < 4; ++m) { const int r = ai * 128 + wr * 64 + m * 16 + fr; sr[ai][m] = saL[u.rowbase + (r < u.rows ? r : 0)]; }
        f32x4 s1[2], s3[2];
#pragma unroll
        for (int bj = 0; bj < 2; ++bj) { const float* p = wsc + (size_t)u.e * 1024 + u.pn * 256 + bj * 128 + wc * 32 + fq * 8; s1[bj] = *(const f32x4*)p; s3[bj] = *(const f32x4*)(p + 4); }
        asm volatile("" ::: "memory");
#pragma unroll
        for (int bj = 0; bj < 2; ++bj) {
            const int hcol = u.pn * 128 + bj * 64 + wc * 16 + fq * 4;
#pragma unroll
            for (int ai = 0; ai < 2; ++ai)
#pragma unroll
                for (int m = 0; m < 4; ++m) { const int row = row0 + ai * 128 + m * 16; const float r = sr[ai][m];
                    const i32x4 a = acc[ai][bj][m][0], b = acc[ai][bj][m][1]; f32x4 h;
#pragma unroll
                    for (int q = 0; q < 4; ++q) { const float av = (float)a[q] * (r * s1[bj][q]), bv = (float)b[q] * (r * s3[bj][q]); h[q] = av * fast_sigmoid(av) * bv; }
                    *(u32x2*)(H + (size_t)row * 512 + hcol) = pack4(h); }
        }
    }
};
struct EpiMoe2 {
    bf16_t* __restrict__ Y; const int* __restrict__ list; const float* __restrict__ gate;
    __device__ __forceinline__ void operator()(const f32x4 (&acc)[2][2][4][2], const Unit& u, int wr, int wc, int fr, int fq) const {
        int slot[2][4]; float g[2][4];
#pragma unroll
        for (int ai = 0; ai < 2; ++ai)
#pragma unroll
            for (int m = 0; m < 4; ++m) { const int r = ai * 128 + wr * 64 + m * 16 + fr; const int rr = r < u.rows ? r : 0;
                slot[ai][m] = list[u.rowbase + rr]; g[ai][m] = gate[u.rowbase + rr]; }
        asm volatile("" ::: "memory");
#pragma unroll
        for (int ai = 0; ai < 2; ++ai)
#pragma unroll
            for (int m = 0; m < 4; ++m) { const int r = ai * 128 + wr * 64 + m * 16 + fr;
                if (r < u.rows) {
#pragma unroll
                    for (int bj = 0; bj < 2; ++bj) { const int col = u.pn * 256 + bj * 128 + wc * 32 + fq * 8;
                        *(u32x4*)(Y + (size_t)slot[ai][m] * 1024 + col) = pack8(acc[ai][bj][m][0] * g[ai][m], acc[ai][bj][m][1] * g[ai][m]); } } }
    }
};

struct Args { const void* in[19]; float* out; unsigned char* ws; int ph_lo, ph_hi, coop, pad; };
struct Frame {
    LAS unsigned char* lds; int tid, lane, wave, vcu, G; unsigned char* ws;
};

template <bool NT, class DstFn>
__device__ __forceinline__ void tr_item(const float* src, int ldw, bf16_t* WT, int ldt, int k0, DstFn dst, LAS float* scr, int lane) {
    const int kr = lane >> 3, c4 = lane & 7;
    f32x4 v[8];
#pragma unroll
    for (int i = 0; i < 8; ++i) { const f32x4* p = (const f32x4*)(src + (size_t)(kr + 8 * i) * ldw + 4 * c4); v[i] = NT ? __builtin_nontemporal_load(p) : *p; }
#pragma unroll
    for (int i = 0; i < 8; ++i) { LAS float* p = scr + (kr + 8 * i) * 33 + 4 * c4; p[0] = v[i].x; p[1] = v[i].y; p[2] = v[i].z; p[3] = v[i].w; }
    LDS_WAIT(); asm volatile("" ::: "memory");
    const int c = lane & 7;
#pragma unroll
    for (int j = 0; j < 4; ++j) { const int n = (lane >> 3) + 8 * j; const LAS float* sp = scr + (8 * c) * 33 + n;
        u32x4 o; o.x = pk2(sp[0 * 33], sp[1 * 33]); o.y = pk2(sp[2 * 33], sp[3 * 33]); o.z = pk2(sp[4 * 33], sp[5 * 33]); o.w = pk2(sp[6 * 33], sp[7 * 33]);
        u32x4* q = (u32x4*)(WT + (size_t)dst(n) * ldt + k0 + 8 * c); if (NT) __builtin_nontemporal_store(o, q); else *q = o; }
    LDS_WAIT(); asm volatile("" ::: "memory");
}
__device__ __forceinline__ int win_dst_row(int sc) {
    if (sc < 1536) return sc;
    if (sc < 1544 + 640) { const int cc = sc - 1544, hd = cc >> 6, d = cc & 63; return 1536 + hd * 64 + 8 * ((d & 31) >> 2) + 4 * (d >> 5) + (d & 3); }
    return sc - 8;
}
__device__ __forceinline__ void sincos_d(double a, double& s, double& c) {
    const double k = __builtin_rint(a * 0.63661977236758134308);
    double r = __builtin_fma(-k, 1.57079632679489655800e+00, a); r = __builtin_fma(-k, 6.12323399573676603587e-17, r);
    const double r2 = r * r;
    double ps = 1.58969099521155010221e-10; ps = __builtin_fma(ps, r2, -2.50507602534068634195e-08); ps = __builtin_fma(ps, r2, 2.75573137070700676789e-06);
    ps = __builtin_fma(ps, r2, -1.98412698298579493134e-04); ps = __builtin_fma(ps, r2, 8.33333333332248946124e-03); ps = __builtin_fma(ps, r2, -1.66666666666666324348e-01);
    const double sr = __builtin_fma(ps * r2, r, r);
    double pc = -1.13596475577881948265e-11; pc = __builtin_fma(pc, r2, 2.08757232129817482790e-09); pc = __builtin_fma(pc, r2, -2.75573143513906633035e-07);
    pc = __builtin_fma(pc, r2, 2.48015872894767294178e-05); pc = __builtin_fma(pc, r2, -1.38888888888741095749e-03); pc = __builtin_fma(pc, r2, 4.16666666666666019037e-02);
    const double cr = __builtin_fma(pc * r2, r2, __builtin_fma(-0.5, r2, 1.0));
    const int q = (int)((long long)k & 3);
    s = (q == 0) ? sr : (q == 1) ? cr : (q == 2) ? -sr : -cr;
    c = (q == 0) ? cr : (q == 1) ? -sr : (q == 2) ? -cr : sr;
}
constexpr int W2_CHUNKS = 342, W13_CHUNKS = 256;
__device__ __forceinline__ void w2_convert_chunk(const Frame& F, const Args& a, int chunk) {
    const float* w2 = (const float*)a.in[17]; bf16_t* W2T = (bf16_t*)(F.ws + WS_W2T);
    int tid = threadIdx.x; asm volatile("" : "+v"(tid));
    const int lane = tid & 63, wave = __builtin_amdgcn_readfirstlane(tid >> 6);
    LAS float* scr = (LAS float*)(F.lds + wave * 8448);
#pragma unroll 1
    for (int k = 0; k < 6; ++k) {
        const int r = chunk * 48 + wave * 6 + k;
        if (r < NE * 8 * 32) { const int e = r >> 8, rr = r & 255, kb = rr / 32, nb = rr % 32;
            tr_item<true>(w2 + (size_t)e * 512 * 1024 + (size_t)(64 * kb) * 1024 + 32 * nb, 1024, W2T + (size_t)e * 1024 * 512, 512, 64 * kb, [=](int n) { return 32 * nb + n; }, scr, lane); }
    }
}
__device__ __forceinline__ void w13q_convert_chunk(const Frame& F, const Args& a, int chunk) {
    const float* w1 = (const float*)a.in[15]; const float* w3 = (const float*)a.in[16];
    signed char* W13Q = (signed char*)(F.ws + WS_W13T); float* wsc = (float*)(F.ws + WS_WSC);
    int tid = threadIdx.x; asm volatile("" : "+v"(tid));
    const int lane = tid & 63, wave = __builtin_amdgcn_readfirstlane(tid >> 6);
    LAS float* scr = (LAS float*)(F.lds + wave * 8448); LAS float* cmx = (LAS float*)(F.lds + 8 * 8448) + wave * 32;
    const int task = chunk * 8 + wave, e = task >> 5, which = (task >> 4) & 1, nb = task & 15;
    const float* src = (which ? w3 : w1) + (size_t)e * 1024 * 512 + 32 * nb;
    const int kr = lane >> 3, c4 = lane & 7;
    f32x4 mx = {0.f, 0.f, 0.f, 0.f};
#define W13_LD8(dst, kb_) do { _Pragma("unroll") for (int i = 0; i < 8; ++i) dst[i] = __builtin_nontemporal_load((const f32x4*)(src + (size_t)(64 * (kb_) + kr + 8 * i) * 512 + 4 * c4)); } while (0)
#define W13_MX8(srcv) do { _Pragma("unroll") for (int i = 0; i < 8; ++i) { mx.x = fmaxf(mx.x, fabsf(srcv[i].x)); mx.y = fmaxf(mx.y, fabsf(srcv[i].y)); mx.z = fmaxf(mx.z, fabsf(srcv[i].z)); mx.w = fmaxf(mx.w, fabsf(srcv[i].w)); } } while (0)
    { f32x4 va[8], vb[8], vc[8];
      W13_LD8(va, 0); W13_LD8(vb, 1);
#pragma unroll 1
      for (int kb = 0; kb < 15; kb += 3) { W13_LD8(vc, kb + 2); W13_MX8(va); W13_LD8(va, kb + 3); W13_MX8(vb); if (kb + 4 < 16) W13_LD8(vb, kb + 4); W13_MX8(vc); }
      W13_MX8(va); }
#undef W13_LD8
#undef W13_MX8
#pragma unroll
    for (int o = 8; o < 64; o <<= 1) { mx.x = fmaxf(mx.x, __shfl_xor(mx.x, o)); mx.y = fmaxf(mx.y, __shfl_xor(mx.y, o)); mx.z = fmaxf(mx.z, __shfl_xor(mx.z, o)); mx.w = fmaxf(mx.w, __shfl_xor(mx.w, o)); }
    if (kr == 0) { cmx[4 * c4 + 0] = mx.x; cmx[4 * c4 + 1] = mx.y; cmx[4 * c4 + 2] = mx.z; cmx[4 * c4 + 3] = mx.w; }
    LDS_WAIT(); asm volatile("" ::: "memory");
    if (lane < 32) { const int u = 32 * nb + lane; wsc[(size_t)e * 1024 + 8 * (u >> 2) + 4 * which + (u & 3)] = cmx[lane] * (1.0f / 127.0f); }
    const int c = lane & 7;
    f32x4 v[8], vn[8], vnn[8];
#pragma unroll
    for (int i = 0; i < 8; ++i) { v[i] = *(const f32x4*)(src + (size_t)(kr + 8 * i) * 512 + 4 * c4); vn[i] = *(const f32x4*)(src + (size_t)(64 + kr + 8 * i) * 512 + 4 * c4); }
#pragma unroll 1
    for (int kb = 0; kb < 16; ++kb) {
        const int kbn = kb + 2 < 16 ? kb + 2 : 15;
#pragma unroll
        for (int i = 0; i < 8; ++i) vnn[i] = *(const f32x4*)(src + (size_t)(64 * kbn + kr + 8 * i) * 512 + 4 * c4);
#pragma unroll
        for (int i = 0; i < 8; ++i) { LAS float* p = scr + (kr + 8 * i) * 33 + 4 * c4; p[0] = v[i].x; p[1] = v[i].y; p[2] = v[i].z; p[3] = v[i].w; }
        LDS_WAIT(); asm volatile("" ::: "memory");
#pragma unroll
        for (int j = 0; j < 4; ++j) { const int n = (lane >> 3) + 8 * j; const LAS float* sp = scr + (8 * c) * 33 + n;
            const float cm = cmx[n]; const float inv = cm > 0.f ? 127.0f / cm : 0.f;
            unsigned lo = 0u, hi = 0u;
#pragma unroll
            for (int i = 0; i < 4; ++i) { lo |= ((unsigned)(int)__builtin_rintf(sp[i * 33] * inv) & 0xffu) << (8 * i); hi |= ((unsigned)(int)__builtin_rintf(sp[(4 + i) * 33] * inv) & 0xffu) << (8 * i); }
            const int u = 32 * nb + n; u32x2 o; o.x = lo; o.y = hi;
            __builtin_nontemporal_store(o, (u32x2*)(W13Q + ((size_t)e * 1024 + 8 * (u >> 2) + 4 * which + (u & 3)) * 1024 + 64 * kb + 8 * c)); }
        LDS_WAIT(); asm volatile("" ::: "memory");
#pragma unroll
        for (int i = 0; i < 8; ++i) { v[i] = vn[i]; vn[i] = vnn[i]; } }
}
__device__ __forceinline__ void p0_prologue(const Frame& F, const Args& a) {
    const float* x = (const float*)a.in[0]; const int* positions = (const int*)a.in[1]; const float* attn_norm = (const float*)a.in[2]; const float* w_in = (const float*)a.in[3];
    const float* b_forget = (const float*)a.in[4]; const float* w_pf = (const float*)a.in[7]; const float* w_ps = (const float*)a.in[8]; const float* w_out = (const float*)a.in[9];
    const float* w_group = (const float*)a.in[11]; const float* w_expert = (const float*)a.in[13]; const float* w1 = (const float*)a.in[15]; const float* w3 = (const float*)a.in[16]; const float* w2 = (const float*)a.in[17];
    unsigned char* ws = F.ws;
    bf16_t* WinT = (bf16_t*)(ws + WS_WIN_T); bf16_t* WpfT = (bf16_t*)(ws + WS_WPF_T); bf16_t* WpsT = (bf16_t*)(ws + WS_WPS_T); bf16_t* WoutT = (bf16_t*)(ws + WS_WOUT_T);
    bf16_t* W13T = (bf16_t*)(ws + WS_W13T); bf16_t* W2T = (bf16_t*)(ws + WS_W2T); bf16_t* Hn = (bf16_t*)(ws + WS_R1);
    float* rope = (float*)(ws + WS_ROPE); float* logf_ = (float*)(ws + WS_LOGF); bf16_t* WrH = (bf16_t*)(ws + WS_WR); bf16_t* WrL = WrH + 80 * 1024;
    LAS float* scr = (LAS float*)(F.lds + F.wave * 8448);
    LAS f32x4* wfl = (LAS f32x4*)(F.lds + 8 * 8448);
    for (int idx = F.tid; idx < 2048; idx += NTHREADS) { const int q = idx >> 7, half = (idx >> 6) & 1, ln = idx & 63, j = q >> 2, i = q & 3, k = 4 * ln + i + 256 * j;
        wfl[idx] = *(const f32x4*)(w_in + (size_t)k * N_IN + 1536 + 4 * half); }
    const int gw = F.vcu * NWAVES + F.wave, NGW = F.G * NWAVES;
    constexpr int I_IN = 16 * 136, I_PF = 8 * 32, I_PS = 8 * 32, I_OUT = 16 * 32;
    constexpr int NITEMS = I_IN + I_PF + I_PS + I_OUT;
    for (int it = gw; it < NITEMS; it += NGW) {
        int r = it;
        if (r < I_IN) { const int kb = r / 136, nb = r % 136; const int n0 = nb < 48 ? 32 * nb : 1544 + 32 * (nb - 48);
            tr_item<false>(w_in + (size_t)(64 * kb) * N_IN + n0, N_IN, WinT, 1024, 64 * kb, [=](int n) { return win_dst_row(n0 + n); }, scr, F.lane); continue; } r -= I_IN;
        if (r < I_PF) { const int kb = r / 32, nb = r % 32; tr_item<false>(w_pf + (size_t)(64 * kb) * 1024 + 32 * nb, 1024, WpfT, 1024, 64 * kb, [=](int n) { return 32 * nb + n; }, scr, F.lane); continue; } r -= I_PF;
        if (r < I_PS) { const int kb = r / 32, nb = r % 32; tr_item<false>(w_ps + (size_t)(64 * kb) * 1024 + 32 * nb, 1024, WpfT, 1024, 512 + 64 * kb, [=](int n) { return 32 * nb + n; }, scr, F.lane); continue; } r -= I_PS;
        { const int kb = r / 32, nb = r % 32; tr_item<false>(w_out + (size_t)(64 * kb) * 1024 + 32 * nb, 1024, WoutT, 1024, 64 * kb, [=](int n) { return 32 * nb + n; }, scr, F.lane); }
    }
    __syncthreads();
    f32x4 gv[4];
#pragma unroll
    for (int j = 0; j < 4; ++j) gv[j] = *((const f32x4*)attn_norm + F.lane + 64 * j);
    for (int m = gw; m < T; m += NGW) {
        const f32x4* xr = (const f32x4*)(x + (size_t)m * DM) + F.lane;
        f32x4 v[4]; float ss = 0.f;
#pragma unroll
        for (int j = 0; j < 4; ++j) { v[j] = xr[64 * j]; ss += (v[j].x * v[j].x + v[j].y * v[j].y) + (v[j].z * v[j].z + v[j].w * v[j].w); }
        const float rstd = 1.0f / sqrtf(wave_sum(ss) * (1.0f / DM) + EPS);
        unsigned long long* o8 = (unsigned long long*)(Hn + (size_t)m * DM) + F.lane;
        float fa[8];
#pragma unroll
        for (int q = 0; q < 8; ++q) fa[q] = 0.f;
#pragma unroll
        for (int j = 0; j < 4; ++j) { v[j] = v[j] * rstd * gv[j];
            o8[64 * j] = (unsigned long long)pk2(v[j].x, v[j].y) | ((unsigned long long)pk2(v[j].z, v[j].w) << 32);
#pragma unroll
            for (int i = 0; i < 4; ++i) { const f32x4 wa = wfl[((j * 4 + i) * 2 + 0) * 64 + F.lane], wb = wfl[((j * 4 + i) * 2 + 1) * 64 + F.lane]; const float hv = v[j][i];
                fa[0] += hv * wa.x; fa[1] += hv * wa.y; fa[2] += hv * wa.z; fa[3] += hv * wa.w; fa[4] += hv * wb.x; fa[5] += hv * wb.y; fa[6] += hv * wb.z; fa[7] += hv * wb.w; } }
#pragma unroll
        for (int q = 0; q < 8; ++q) fa[q] = wave_sum(fa[q]);
        float z = fa[0];
#pragma unroll
        for (int q = 1; q < 8; ++q) z = (F.lane == q) ? fa[q] : z;
        if (F.lane < 8) { const float y = z + b_forget[F.lane]; const float ls = fminf(y, 0.f) - log1pf(__expf(-fabsf(y))); logf_[(size_t)m * 8 + F.lane] = ls; }
    }
    const int gt = F.vcu * NTHREADS + F.tid, NGT = F.G * NTHREADS;
    { const int i = gt & 31;
      const double invf = exp2(-(double)i * (13.287712379549449 / 32.0));
      for (int idx = gt; idx < T * 32; idx += 4 * NGT) {
          int pos[4];
#pragma unroll
          for (int k = 0; k < 4; ++k) { const int t = (idx + k * NGT) >> 5; pos[k] = t < T ? positions[t] : 0; }
#pragma unroll
          for (int k = 0; k < 4; ++k) { const int t = (idx + k * NGT) >> 5; if (t < T) { double s, c; sincos_d((double)pos[k] * invf, s, c);
              rope[(size_t)t * 64 + i] = (float)c; rope[(size_t)t * 64 + 32 + i] = (float)s; } } } }
    for (int idx = gt; idx < 80 * 1024; idx += NGT) { const int j = idx >> 10, k = idx & 1023;
        const float w = j < 8 ? w_group[k * 8 + j] : (j < 72 ? w_expert[k * 64 + (j - 8)] : 0.f);
        const unsigned h = f2bf(w); WrH[idx] = (bf16_t)h; WrL[idx] = (bf16_t)f2bf(w - bf2f(h)); }
}

__device__ __forceinline__ void cumsum_block(const Frame& F, int seq) {
    const float* logf_ = (const float*)(F.ws + WS_LOGF); float* cum = (float*)(F.ws + WS_CUM);
    const int b = seq >> 3, h = seq & 7; const int s0 = F.tid * 16;
    double loc[16]; double run = 0.0;
#pragma unroll
    for (int i = 0; i < 16; ++i) { run += (double)logf_[((size_t)b * SEQ + s0 + i) * 8 + h]; loc[i] = run; }
    double inc = run;
#pragma unroll
    for (int o = 1; o < 64; o <<= 1) { const double t = __shfl_up(inc, o); if (F.lane >= o) inc += t; }
    LAS double* wt = (LAS double*)(F.lds + MISC_OFF + 1024);
    if (F.lane == 63) wt[F.wave] = inc;
    __syncthreads();
    double off = inc - run;
#pragma unroll
    for (int w = 0; w < 8; ++w) if (w < F.wave) off += wt[w];
#pragma unroll
    for (int i = 0; i < 16; ++i) cum[((size_t)b * 8 + h) * SEQ + s0 + i] = (float)((off + loc[i]) * 1.4426950408889634);
    __syncthreads();
}

__device__ __forceinline__ int crow(int r, int hi) { return (r & 3) + 8 * (r >> 2) + 4 * hi; }
__device__ __forceinline__ void attn_pv(f32x16* o, int vb, bf16x8 pa0, bf16x8 pa1, bf16x8 pa2, bf16x8 pa3) {
#pragma unroll
    for (int d0 = 0; d0 < 2; ++d0) { s16x4 lo[4], hi[4];
#pragma unroll
        for (int ks = 0; ks < 4; ++ks) {
            asm volatile("ds_read_b64_tr_b16 %0,%1 offset:%c2" : "=&v"(lo[ks]) : "v"(vb), "i"(d0 * 4096 + ks * 1024) : "memory");
            asm volatile("ds_read_b64_tr_b16 %0,%1 offset:%c2" : "=&v"(hi[ks]) : "v"(vb), "i"(d0 * 4096 + ks * 1024 + 512) : "memory"); }
        asm volatile("s_waitcnt lgkmcnt(0)" ::: "memory"); __builtin_amdgcn_sched_barrier(0);
#define PK(k) (bf16x8){lo[k][0], lo[k][1], lo[k][2], lo[k][3], hi[k][0], hi[k][1], hi[k][2], hi[k][3]}
        o[d0] = __builtin_amdgcn_mfma_f32_32x32x16_bf16(pa0, PK(0), o[d0], 0, 0, 0);
        o[d0] = __builtin_amdgcn_mfma_f32_32x32x16_bf16(pa1, PK(1), o[d0], 0, 0, 0);
        o[d0] = __builtin_amdgcn_mfma_f32_32x32x16_bf16(pa2, PK(2), o[d0], 0, 0, 0);
        o[d0] = __builtin_amdgcn_mfma_f32_32x32x16_bf16(pa3, PK(3), o[d0], 0, 0, 0);
#undef PK
    }
}
template <bool FOX>
__device__ __forceinline__ void attn_unit(LAS unsigned char* lds, const bf16_t* Qp, int ldq, const bf16_t* Kp, const bf16_t* Vp, int ldkv, bf16_t* Op, int ldo, const float* cum, float sink2, int q0) {
    int tid = threadIdx.x; asm volatile("" : "+v"(tid));
    const int lane = tid & 63, r32 = lane & 31, hi = lane >> 5; const int wid = __builtin_amdgcn_readfirstlane(tid >> 6);
    LAS unsigned char* Kl = lds; LAS unsigned char* Vl = lds + 8192; LAS float* csl = (LAS float*)(lds + 16384); LAS float* wsf = (LAS float*)(lds + 16384 + 256) + wid * 64;
    const int qw0 = q0 + wid * 32, qpos = qw0 + r32;
    bf16x8 qr[4];
#pragma unroll
    for (int d0 = 0; d0 < 4; ++d0) qr[d0] = *(const bf16x8*)(Qp + (size_t)qpos * ldq + d0 * 16 + hi * 8);
    const float ctq = FOX ? cum[qpos] : 0.f;
    float mrow = FOX ? -1e30f : sink2; float lrow = FOX ? 0.f : (hi == 0 ? 1.f : 0.f);
    f32x16 o[2];
#pragma unroll
    for (int r = 0; r < 16; ++r) { o[0][r] = 0.f; o[1][r] = 0.f; }
    const int t_lo = FOX ? 0 : (q0 / 64 - 2 < 0 ? 0 : q0 / 64 - 2), t_hi = q0 / 64 + 4;
    const int vb = (int)(unsigned)(uintptr_t)Vl + ((lane >> 4) & 1) * 32 + (lane & 3) * 8 + (4 * hi + ((lane & 15) >> 2)) * 64;
    for (int t = t_lo; t < t_hi; ++t) {
        __syncthreads();
        { const u32x4 kv = *(const u32x4*)(Kp + (size_t)(64 * t + lane) * ldkv + wid * 8);
          const u32x4 vv = *(const u32x4*)(Vp + (size_t)(64 * t + 16 * (wid & 3) + (lane >> 2)) * ldkv + (wid >> 2) * 32 + (lane & 3) * 8);
          *(LAS u32x4*)(Kl + wid * 1024 + lane * 16) = kv; *(LAS u32x4*)(Vl + wid * 1024 + lane * 16) = vv;
          if (FOX && tid < 64) csl[tid] = cum[64 * t + tid]; }
        __syncthreads();
        const bool rel = (64 * t <= qw0 + 31) && (FOX || (64 * t + 63 >= qw0 - (WINDOW - 1)));
        if (rel) {
            f32x16 p0, p1;
#pragma unroll
            for (int r = 0; r < 16; ++r) { p0[r] = 0.f; p1[r] = 0.f; }
            { const LAS unsigned char* kb = Kl + hi * 1024 + r32 * 16;
#pragma unroll
              for (int d0 = 0; d0 < 4; ++d0) { const bf16x8 b0 = *(const LAS bf16x8*)(kb + d0 * 2048), b1 = *(const LAS bf16x8*)(kb + d0 * 2048 + 512);
                  p0 = __builtin_amdgcn_mfma_f32_32x32x16_bf16(b0, qr[d0], p0, 0, 0, 0); p1 = __builtin_amdgcn_mfma_f32_32x32x16_bf16(b1, qr[d0], p1, 0, 0, 0); } }
            float rm = -1e30f;
#pragma unroll
            for (int r = 0; r < 16; ++r) { const int kr = crow(r, hi); const int kv0 = 64 * t + kr, kv1 = kv0 + 32;
                float s0 = p0[r], s1 = p1[r];
                if (FOX) { s0 += ctq - csl[kr]; s1 += ctq - csl[kr + 32]; }
                const bool v0 = (kv0 <= qpos) && (FOX || (qpos - kv0 < WINDOW)), v1 = (kv1 <= qpos) && (FOX || (qpos - kv1 < WINDOW));
                s0 = v0 ? s0 : -1e30f; s1 = v1 ? s1 : -1e30f; p0[r] = s0; p1[r] = s1; rm = fmaxf(rm, fmaxf(s0, s1)); }
            rm = fmaxf(rm, __shfl_xor(rm, 32));
            const float mnew = fmaxf(mrow, rm); const float f = __builtin_amdgcn_exp2f(mrow - mnew); mrow = mnew;
            float ls = 0.f;
#pragma unroll
            for (int r = 0; r < 16; ++r) { p0[r] = __builtin_amdgcn_exp2f(p0[r] - mnew); p1[r] = __builtin_amdgcn_exp2f(p1[r] - mnew); ls += p0[r] + p1[r]; }
            lrow = lrow * f + ls;
            if (__any(f != 1.0f)) {
                if (hi == 0) wsf[r32] = f;
                LDS_WAIT();
#pragma unroll
                for (int r = 0; r < 16; ++r) { const float fr_ = wsf[crow(r, hi)]; o[0][r] *= fr_; o[1][r] *= fr_; }
            }
            u32x4 w0, w1, w2, w3;
            w0.x = cvt_pk_bf16(p0[0], p0[1]); w0.y = cvt_pk_bf16(p0[2], p0[3]); w0.z = cvt_pk_bf16(p0[4], p0[5]); w0.w = cvt_pk_bf16(p0[6], p0[7]);
            w1.x = cvt_pk_bf16(p0[8], p0[9]); w1.y = cvt_pk_bf16(p0[10], p0[11]); w1.z = cvt_pk_bf16(p0[12], p0[13]); w1.w = cvt_pk_bf16(p0[14], p0[15]);
            w2.x = cvt_pk_bf16(p1[0], p1[1]); w2.y = cvt_pk_bf16(p1[2], p1[3]); w2.z = cvt_pk_bf16(p1[4], p1[5]); w2.w = cvt_pk_bf16(p1[6], p1[7]);
            w3.x = cvt_pk_bf16(p1[8], p1[9]); w3.y = cvt_pk_bf16(p1[10], p1[11]); w3.z = cvt_pk_bf16(p1[12], p1[13]); w3.w = cvt_pk_bf16(p1[14], p1[15]);
            attn_pv(o, vb, __builtin_bit_cast(bf16x8, w0), __builtin_bit_cast(bf16x8, w1), __builtin_bit_cast(bf16x8, w2), __builtin_bit_cast(bf16x8, w3));
        }
    }
    lrow += __shfl_xor(lrow, 32);
    if (hi == 0) wsf[32 + r32] = 1.0f / lrow;
    LDS_WAIT();
#pragma unroll
    for (int r = 0; r < 16; ++r) { const int qr_ = crow(r, hi); const float il = wsf[32 + qr_];
        bf16_t* op = Op + (size_t)(qw0 + qr_) * ldo + r32;
        op[0] = (bf16_t)f2bf(o[0][r] * il); op[32] = (bf16_t)f2bf(o[1][r] * il); }
}
__device__ __forceinline__ void swa_unit(LAS unsigned char* lds, const bf16_t* __restrict__ QS, const bf16_t* __restrict__ KS, const bf16_t* __restrict__ VS, bf16_t* __restrict__ OS, const float* __restrict__ sinks, int b, int g, int n) {
    int tid = threadIdx.x; asm volatile("" : "+v"(tid));
    const int lane = tid & 63, r32 = lane & 31, hi = lane >> 5; const int wid = __builtin_amdgcn_readfirstlane(tid >> 6);
    LAS unsigned char* Kl = lds; LAS unsigned char* Vl = lds + 49152; LAS float* wsf = (LAS float*)(lds + 98304) + wid * 64; LAS bf16_t* stg = (LAS bf16_t*)(lds + 100352) + wid * 1024;
    const int kbase = 256 * n - 128;
    const bf16_t* Kp = KS + (size_t)b * SEQ * 128 + g * 64; const bf16_t* Vp = VS + (size_t)b * SEQ * 128 + g * 64;
    { u32x4 kv[6], vv[6];
#pragma unroll
      for (int t = 0; t < 6; ++t) { const int p0 = kbase + 64 * t; const int pk = p0 < 0 ? 0 : p0;
          kv[t] = *(const u32x4*)(Kp + (size_t)(pk + lane) * 128 + wid * 8);
          vv[t] = *(const u32x4*)(Vp + (size_t)(pk + 16 * (wid & 3) + (lane >> 2)) * 128 + (wid >> 2) * 32 + (lane & 3) * 8); }
#pragma unroll
      for (int t = 0; t < 6; ++t) { *(LAS u32x4*)(Kl + t * 8192 + wid * 1024 + lane * 16) = kv[t]; *(LAS u32x4*)(Vl + t * 8192 + wid * 1024 + lane * 16) = vv[t]; } }
    const int h = 4 * g + (wid >> 1);
    const float sink2 = sinks[h] * LOG2E;
    const bf16_t* Qp = QS + (size_t)b * SEQ * 512 + h * 64; bf16_t* Op = OS + (size_t)b * SEQ * 1024 + h * 64;
    bf16x8 qr[4][4];
#pragma unroll
    for (int i = 0; i < 4; ++i) { const int qpos = 256 * n + 128 * (wid & 1) + 32 * i + r32;
#pragma unroll
        for (int d0 = 0; d0 < 4; ++d0) qr[i][d0] = *(const bf16x8*)(Qp + (size_t)qpos * 512 + d0 * 16 + hi * 8); }
    __syncthreads();
#pragma unroll
    for (int i = 0; i < 4; ++i) {
        const int r0 = 128 * (wid & 1) + 32 * i, qpos = 256 * n + r0 + r32;
        float mrow = sink2, lrow = (hi == 0) ? 1.f : 0.f;
        f32x16 o[2];
#pragma unroll
        for (int r = 0; r < 16; ++r) { o[0][r] = 0.f; o[1][r] = 0.f; }
        const int j0 = (r0 + 1) >> 6;
#pragma unroll 1
        for (int j = j0; j < j0 + 3; ++j) {
            const int kp0 = kbase + 64 * j;
            if (kp0 < 0) continue;
            f32x16 p0, p1;
#pragma unroll
            for (int r = 0; r < 16; ++r) { p0[r] = 0.f; p1[r] = 0.f; }
            { const LAS unsigned char* kb = Kl + j * 8192 + hi * 1024 + r32 * 16;
#pragma unroll
              for (int d0 = 0; d0 < 4; ++d0) { const bf16x8 b0 = *(const LAS bf16x8*)(kb + d0 * 2048), b1 = *(const LAS bf16x8*)(kb + d0 * 2048 + 512);
                  p0 = __builtin_amdgcn_mfma_f32_32x32x16_bf16(b0, qr[i][d0], p0, 0, 0, 0); p1 = __builtin_amdgcn_mfma_f32_32x32x16_bf16(b1, qr[i][d0], p1, 0, 0, 0); } }
            float rm = -1e30f;
#pragma unroll
            for (int r = 0; r < 16; ++r) { const int kv0 = kp0 + crow(r, hi), kv1 = kv0 + 32;
                const bool v0 = (kv0 <= qpos) && (qpos - kv0 < WINDOW), v1 = (kv1 <= qpos) && (qpos - kv1 < WINDOW);
                const float s0 = v0 ? p0[r] : -1e30f, s1 = v1 ? p1[r] : -1e30f; p0[r] = s0; p1[r] = s1; rm = fmaxf(rm, fmaxf(s0, s1)); }
            rm = fmaxf(rm, __shfl_xor(rm, 32));
            const float mnew = fmaxf(mrow, rm); const float f = __builtin_amdgcn_exp2f(mrow - mnew); mrow = mnew;
            float ls = 0.f;
#pragma unroll
            for (int r = 0; r < 16; ++r) { p0[r] = __builtin_amdgcn_exp2f(p0[r] - mnew); p1[r] = __builtin_amdgcn_exp2f(p1[r] - mnew); ls += p0[r] + p1[r]; }
            lrow = lrow * f + ls;
            if (__any(f != 1.0f)) {
                if (hi == 0) wsf[r32] = f;
                LDS_WAIT();
#pragma unroll
                for (int r = 0; r < 16; ++r) { const float fr_ = wsf[crow(r, hi)]; o[0][r] *= fr_; o[1][r] *= fr_; }
            }
            u32x4 w0, w1, w2, w3;
            w0.x = cvt_pk_bf16(p0[0], p0[1]); w0.y = cvt_pk_bf16(p0[2], p0[3]); w0.z = cvt_pk_bf16(p0[4], p0[5]); w0.w = cvt_pk_bf16(p0[6], p0[7]);
            w1.x = cvt_pk_bf16(p0[8], p0[9]); w1.y = cvt_pk_bf16(p0[10], p0[11]); w1.z = cvt_pk_bf16(p0[12], p0[13]); w1.w = cvt_pk_bf16(p0[14], p0[15]);
            w2.x = cvt_pk_bf16(p1[0], p1[1]); w2.y = cvt_pk_bf16(p1[2], p1[3]); w2.z = cvt_pk_bf16(p1[4], p1[5]); w2.w = cvt_pk_bf16(p1[6], p1[7]);
            w3.x = cvt_pk_bf16(p1[8], p1[9]); w3.y = cvt_pk_bf16(p1[10], p1[11]); w3.z = cvt_pk_bf16(p1[12], p1[13]); w3.w = cvt_pk_bf16(p1[14], p1[15]);
            const int vb = (int)(unsigned)(uintptr_t)(Vl + j * 8192) + ((lane >> 4) & 1) * 32 + (lane & 3) * 8 + (4 * hi + ((lane & 15) >> 2)) * 64;
            attn_pv(o, vb, __builtin_bit_cast(bf16x8, w0), __builtin_bit_cast(bf16x8, w1), __builtin_bit_cast(bf16x8, w2), __builtin_bit_cast(bf16x8, w3));
        }
        lrow += __shfl_xor(lrow, 32);
        if (hi == 0) wsf[32 + r32] = 1.0f / lrow;
        LDS_WAIT();
        float il[16];
#pragma unroll
        for (int r = 0; r < 16; ++r) il[r] = wsf[32 + crow(r, hi)];
#pragma unroll
        for (int d0 = 0; d0 < 2; ++d0) {
#pragma unroll
            for (int r = 0; r < 16; ++r) stg[crow(r, hi) * 32 + r32] = (bf16_t)f2bf(o[d0][r] * il[r]);
            LDS_WAIT();
#pragma unroll
            for (int q = 0; q < 2; ++q) { const int row = q * 16 + (lane >> 2), ch = lane & 3; const u32x4 vv_ = *(const LAS u32x4*)(stg + row * 32 + ch * 8);
                *(u32x4*)(Op + (size_t)(256 * n + r0 + row) * 1024 + d0 * 32 + ch * 8) = vv_; }
            LDS_WAIT(); }
    }
    __syncthreads();
}
__device__ __forceinline__ void p2_attention(const Frame& F, const Args& a) {
    unsigned char* ws = F.ws; const float* sinks = (const float*)a.in[6];
    const bf16_t* QF = (const bf16_t*)(ws + WS_QF); const bf16_t* KF = (const bf16_t*)(ws + WS_KF); const bf16_t* VF = (const bf16_t*)(ws + WS_VF);
    const bf16_t* QS = (const bf16_t*)(ws + WS_QS); const bf16_t* KS = (const bf16_t*)(ws + WS_KS); const bf16_t* VS = (const bf16_t*)(ws + WS_VS);
    bf16_t* OF = (bf16_t*)(ws + WS_R1); bf16_t* OS = OF + 512; const float* cum = (const float*)(ws + WS_CUM);
    unsigned* queue = (unsigned*)(ws + WS_CTL + CTL_QUEUE_OFF); const unsigned* nrm = (const unsigned*)(ws + WS_CTL + CTL_NRM_OFF);
    volatile LAS int* qslot = (volatile LAS int*)(F.lds + MISC_OFF + 4096);
#pragma unroll 1
    for (;;) {
        if (threadIdx.x == 0) *qslot = (int)atomicAdd(queue, 1u);
        __syncthreads();
        const int u = __builtin_amdgcn_readfirstlane(*qslot);
        const int C0 = (F.G == 256) ? 128 : 0, NCQ = W13_CHUNKS + W2_CHUNKS - C0;
        if (u >= NCQ + 1024 + 256) break;
        int f = -1, c = -1, v = -1;
        if (u < 2 * NCQ) { if (u & 1) { const int ci = u >> 1; c = ci < W13_CHUNKS ? W2_CHUNKS + ci : C0 + (ci - W13_CHUNKS); } else f = u >> 1; }
        else if (u < 2 * NCQ + 256) v = u - 2 * NCQ;
        else f = u - NCQ - 256;
        if (f >= 0) { const int qb = 31 - (f >> 5), bh = f & 31;
            attn_body::attn_unit<64>(bh >> 3, bh & 7, qb, (const attn_body::bf16*)QF, (const attn_body::bf16*)KF, (const attn_body::bf16*)VF, (attn_body::bf16*)OF, cum, nrm, (char*)F.lds); }
        else if (c >= 0) { if (c < W2_CHUNKS) w2_convert_chunk(F, a, c); else w13q_convert_chunk(F, a, c - W2_CHUNKS); __syncthreads(); }
        else { swa_unit(F.lds, QS, KS, VS, OS, sinks, v >> 6, (v >> 5) & 1, v & 31); }
    }
    __syncthreads();
}

__device__ __forceinline__ void p5_router(const Frame& F, const Args& a) {
    unsigned char* ws = F.ws; const bf16_t* x1 = (const bf16_t*)(ws + WS_X1B); const float* ffn_norm = (const float*)a.in[10]; const float* b_group = (const float*)a.in[12]; const float* b_expert = (const float*)a.in[14];
    signed char* H2 = (signed char*)(ws + WS_R1); float* saL = (float*)(ws + WS_SAL); const bf16_t* WrH = (const bf16_t*)(ws + WS_WR); const bf16_t* WrL = WrH + 80 * 1024;
    int* cnt = (int*)(ws + WS_CTL); int* list = (int*)(ws + WS_LIST); float* gate = (float*)(ws + WS_GATE);
    constexpr int WROW = 272, WMAT = 80 * WROW, WBUF = 2 * WMAT;
    LAS unsigned char* WB = F.lds; LAS float* GN = (LAS float*)(F.lds + 2 * WBUF); LAS float* LG = (LAS float*)(F.lds + 2 * WBUF + 4096) + F.wave * (16 * 80);
    const int fr = F.lane & 15, fq = F.lane >> 4;
    LAS int* lcnt = (LAS int*)(F.lds + MISC_OFF + 3072); LAS int* lbase = lcnt + 64;
    if (F.tid < NE) lcnt[F.tid] = 0;
    for (int idx = F.tid; idx < 256; idx += NTHREADS) *(LAS f32x4*)(GN + idx * 4) = *(const f32x4*)(ffn_norm + idx * 4);
    __syncthreads();
    const bf16_t* wsrc = WrH + (size_t)(F.tid >> 4) * 1024 + (F.tid & 15) * 8; LAS unsigned char* wdst = WB + (F.tid >> 4) * WROW + (F.tid & 15) * 16;
#define P5_WLOAD(dst, kc) do { _Pragma("unroll") for (int i_ = 0; i_ < 5; ++i_) dst[i_] = *(const u32x4*)(wsrc + i_ * 32 * 1024 + (kc) * 128); } while (0)
#define P5_WSTORE(src, buf) do { _Pragma("unroll") for (int i_ = 0; i_ < 5; ++i_) *(LAS u32x4*)(wdst + (buf) * WBUF + i_ * 32 * WROW) = src[i_]; } while (0)
#define P5_XLOAD(dst, kc) do { _Pragma("unroll") for (int s_ = 0; s_ < 4; ++s_) dst[s_] = *(const u32x4*)(xrow + (kc) * 128 + s_ * 32); } while (0)
#pragma unroll 1
    for (int chunk = F.vcu; chunk < T / 128; chunk += F.G) {
        const int row = chunk * 128 + F.wave * 16 + fr;
        const bf16_t* xrow = x1 + (size_t)row * DM + fq * 8;
        u32x4 wreg[5]; u32x4 xa[4], xn[4];
        P5_WLOAD(wreg, 0);
        float ss = 0.f; float am = 0.f;
#pragma unroll 16
        for (int s = 0; s < 32; ++s) { const u32x4 w = *(const u32x4*)(xrow + 32 * s);
            const f32x4 g0 = *(const LAS f32x4*)(GN + 32 * s + fq * 8), g1 = *(const LAS f32x4*)(GN + 32 * s + fq * 8 + 4);
            ss += (BFLO(w.x) * BFLO(w.x) + BFHI(w.x) * BFHI(w.x)) + (BFLO(w.y) * BFLO(w.y) + BFHI(w.y) * BFHI(w.y)) + (BFLO(w.z) * BFLO(w.z) + BFHI(w.z) * BFHI(w.z)) + (BFLO(w.w) * BFLO(w.w) + BFHI(w.w) * BFHI(w.w));
            am = fmaxf(am, fmaxf(fmaxf(fabsf(BFLO(w.x) * g0.x), fabsf(BFHI(w.x) * g0.y)), fmaxf(fabsf(BFLO(w.y) * g0.z), fabsf(BFHI(w.y) * g0.w))));
            am = fmaxf(am, fmaxf(fmaxf(fabsf(BFLO(w.z) * g1.x), fabsf(BFHI(w.z) * g1.y)), fmaxf(fabsf(BFLO(w.w) * g1.z), fabsf(BFHI(w.w) * g1.w)))); }
        ss += __shfl_xor(ss, 16); ss += __shfl_xor(ss, 32);
        am = fmaxf(am, __shfl_xor(am, 16)); am = fmaxf(am, __shfl_xor(am, 32));
        const float rstd = 1.0f / sqrtf(ss * (1.0f / DM) + EPS);
        const float hmax = am * rstd * 1.0001f;
        const float qinv = hmax > 0.f ? 127.0f / hmax : 0.f;
        P5_XLOAD(xa, 0);
        __syncthreads();
        P5_WSTORE(wreg, 0);
        f32x4 acc[5];
#pragma unroll
        for (int n = 0; n < 5; ++n) acc[n] = (f32x4){0.f, 0.f, 0.f, 0.f};
#pragma unroll 1
        for (int kc = 0; kc < 8; ++kc) {
            if (kc < 7) { P5_WLOAD(wreg, kc + 1); P5_XLOAD(xn, kc + 1); }
            __syncthreads();
            const LAS unsigned char* WH = WB + (kc & 1) * WBUF; const LAS unsigned char* WL = WH + WMAT;
#pragma unroll
            for (int s4 = 0; s4 < 4; ++s4) { const int k0 = kc * 128 + s4 * 32 + fq * 8;
                const f32x4 g0 = *(const LAS f32x4*)(GN + k0), g1 = *(const LAS f32x4*)(GN + k0 + 4);
                const u32x4 xw = xa[s4]; const f32x4 x0 = {BFLO(xw.x), BFHI(xw.x), BFLO(xw.y), BFHI(xw.y)}, x1v = {BFLO(xw.z), BFHI(xw.z), BFLO(xw.w), BFHI(xw.w)};
                const f32x4 h0 = x0 * rstd * g0, h1 = x1v * rstd * g1;
                const u32x4 hh = pack8(h0, h1);
                f32x4 r0, r1;
                r0[0] = h0[0] - bf2f(hh.x & 0xffffu); r0[1] = h0[1] - bf2f(hh.x >> 16); r0[2] = h0[2] - bf2f(hh.y & 0xffffu); r0[3] = h0[3] - bf2f(hh.y >> 16);
                r1[0] = h1[0] - bf2f(hh.z & 0xffffu); r1[1] = h1[1] - bf2f(hh.z >> 16); r1[2] = h1[2] - bf2f(hh.w & 0xffffu); r1[3] = h1[3] - bf2f(hh.w >> 16);
                const u32x4 hl = pack8(r0, r1);
                { unsigned lo = 0u, hi_ = 0u;
#pragma unroll
                  for (int q = 0; q < 4; ++q) { lo |= ((unsigned)(int)__builtin_rintf(h0[q] * qinv) & 0xffu) << (8 * q); hi_ |= ((unsigned)(int)__builtin_rintf(h1[q] * qinv) & 0xffu) << (8 * q); }
                  u32x2 qw; qw.x = lo; qw.y = hi_; *(u32x2*)(H2 + (size_t)row * DM + k0) = qw; }
                const bf16x8 ah = __builtin_bit_cast(bf16x8, hh), al = __builtin_bit_cast(bf16x8, hl);
#pragma unroll
                for (int n = 0; n < 5; ++n) { const int bo = (n * 16 + fr) * WROW + (s4 * 32 + fq * 8) * 2;
                    const bf16x8 bh = *(const LAS bf16x8*)(WH + bo), bl = *(const LAS bf16x8*)(WL + bo);
                    acc[n] = __builtin_amdgcn_mfma_f32_16x16x32_bf16(ah, bh, acc[n], 0, 0, 0);
                    acc[n] = __builtin_amdgcn_mfma_f32_16x16x32_bf16(al, bh, acc[n], 0, 0, 0);
                    acc[n] = __builtin_amdgcn_mfma_f32_16x16x32_bf16(ah, bl, acc[n], 0, 0, 0); } }
            if (kc < 7) { P5_WSTORE(wreg, (kc + 1) & 1);
#pragma unroll
                for (int i = 0; i < 4; ++i) xa[i] = xn[i]; }
        }
#pragma unroll
        for (int n = 0; n < 5; ++n)
#pragma unroll
            for (int r = 0; r < 4; ++r) LG[(4 * fq + r) * 80 + n * 16 + fr] = acc[n][r];
        LDS_WAIT();
        int e0 = 0, e1 = 0, q0 = 0, q1 = 0, tok_ = 0; float g0_ = 0.f, g1_ = 0.f;
        if (F.lane < 16) {
            const int tok = chunk * 128 + F.wave * 16 + F.lane; const LAS float* lg = LG + F.lane * 80;
            float gl[8]; float gm = -1e30f; int gi = 0;
#pragma unroll
            for (int j = 0; j < 8; ++j) { gl[j] = lg[j] + b_group[j]; if (gl[j] > gm) { gm = gl[j]; gi = j; } }
            float den = 0.f;
#pragma unroll
            for (int j = 0; j < 8; ++j) den += __expf(gl[j] - gm);
            const float gw = 1.0f / den;
            float v0 = -1e30f, v1 = -1e30f; int i0 = 0, i1 = 0;
#pragma unroll
            for (int j = 0; j < 8; ++j) { const float e = lg[8 + gi * 8 + j] + b_expert[gi * 8 + j];
                if (e > v0) { v1 = v0; i1 = i0; v0 = e; i0 = j; } else if (e > v1) { v1 = e; i1 = j; } }
            const float ex = __expf(v1 - v0); const float p0 = 1.0f / (1.0f + ex);
            e0 = gi * 8 + i0; e1 = gi * 8 + i1; tok_ = tok;
            q0 = __hip_atomic_fetch_add(&lcnt[e0], 1, __ATOMIC_RELAXED, __HIP_MEMORY_SCOPE_WORKGROUP); q1 = __hip_atomic_fetch_add(&lcnt[e1], 1, __ATOMIC_RELAXED, __HIP_MEMORY_SCOPE_WORKGROUP);
            g0_ = gw * p0; g1_ = gw * ex * p0;
        }
        __syncthreads();
        if (F.tid < NE) { const int c = lcnt[F.tid]; lbase[F.tid] = c ? atomicAdd(&cnt[F.tid * 64], c) : 0; lcnt[F.tid] = 0; }
        __syncthreads();
        if (F.lane < 16) { const size_t i0_ = (size_t)e0 * T + lbase[e0] + q0, i1_ = (size_t)e1 * T + lbase[e1] + q1; list[i0_] = tok_ * 2; list[i1_] = tok_ * 2 + 1; gate[i0_] = g0_; gate[i1_] = g1_; saL[i0_] = hmax * (1.0f / 127.0f); saL[i1_] = hmax * (1.0f / 127.0f); }
    }
#undef P5_WLOAD
#undef P5_WSTORE
#undef P5_XLOAD
    __syncthreads();
}

__device__ __forceinline__ void p8_final(const Frame& F, const Args& a) {
    const float* final_norm = (const float*)a.in[18]; float* out = a.out; const bf16_t* Y = (const bf16_t*)(F.ws + WS_YBUF); const bf16_t* X1 = (const bf16_t*)(F.ws + WS_X1B);
    const int gw = F.vcu * NWAVES + F.wave, NGW = F.G * NWAVES;
    f32x4 gv[4];
#pragma unroll
    for (int j = 0; j < 2; ++j) { gv[2 * j] = *(const f32x4*)(final_norm + 8 * F.lane + 512 * j); gv[2 * j + 1] = *(const f32x4*)(final_norm + 8 * F.lane + 512 * j + 4); }
    constexpr int R = 2;
    for (int m0 = gw * R; m0 < T; m0 += NGW * R) {
        u32x4 xw[R][2], ya[R][2], yb[R][2];
#pragma unroll
        for (int r = 0; r < R; ++r)
#pragma unroll
            for (int j = 0; j < 2; ++j) { const size_t m = m0 + r; const int co = 8 * F.lane + 512 * j;
                xw[r][j] = *(const u32x4*)(X1 + m * DM + co); ya[r][j] = *(const u32x4*)(Y + (2 * m) * DM + co); yb[r][j] = *(const u32x4*)(Y + (2 * m + 1) * DM + co); }
#pragma unroll
        for (int r = 0; r < R; ++r) {
            f32x4 v[4]; float ss = 0.f;
#pragma unroll
            for (int j = 0; j < 2; ++j) { const u32x4 x = xw[r][j], p = ya[r][j], q = yb[r][j];
                v[2 * j] = (f32x4){BFLO(x.x) + BFLO(p.x) + BFLO(q.x), BFHI(x.x) + BFHI(p.x) + BFHI(q.x), BFLO(x.y) + BFLO(p.y) + BFLO(q.y), BFHI(x.y) + BFHI(p.y) + BFHI(q.y)};
                v[2 * j + 1] = (f32x4){BFLO(x.z) + BFLO(p.z) + BFLO(q.z), BFHI(x.z) + BFHI(p.z) + BFHI(q.z), BFLO(x.w) + BFLO(p.w) + BFLO(q.w), BFHI(x.w) + BFHI(p.w) + BFHI(q.w)}; }
#pragma unroll
            for (int i = 0; i < 4; ++i) ss += (v[i].x * v[i].x + v[i].y * v[i].y) + (v[i].z * v[i].z + v[i].w * v[i].w);
            const float rstd = 1.0f / sqrtf(wave_sum(ss) * (1.0f / DM) + EPS);
            float* orow = out + (size_t)(m0 + r) * DM + 8 * F.lane;
#pragma unroll
            for (int j = 0; j < 2; ++j) { *(f32x4*)(orow + 512 * j) = v[2 * j] * rstd * gv[2 * j]; *(f32x4*)(orow + 512 * j + 4) = v[2 * j + 1] * rstd * gv[2 * j + 1]; }
        }
    }
}

__device__ __forceinline__ MoeTab moe_table(const Frame& F) {
    LAS int* pre = (LAS int*)(F.lds + MISC_OFF + 2048); LAS int* cn = pre + 80;
    const int* cnt = (const int*)(F.ws + WS_CTL);
    __syncthreads();
    if (F.tid < 64) {
        const int c = cnt[F.lane * 64]; const int nb = (c + 255) >> 8; int inc = nb;
#pragma unroll
        for (int o = 1; o < 64; o <<= 1) { const int t = __shfl_up(inc, o); if (F.lane >= o) inc += t; }
        pre[F.lane] = inc - nb; cn[F.lane] = c;
        if (F.lane == 63) { pre[NE] = inc; pre[NE + 1] = 0x7fffffff; } }
    __syncthreads();
    MoeTab tb; tb.pre = pre; tb.cnt = cn; return tb;
}

#define XB_TMO      128
#define XB_XCNT(j)  (256  + 64 * (j))
#define XB_XSUB(j)  (1280 + 64 * (j))
#define XB_XGEN(j)  (2304 + 64 * (j))
#define XB_TOP      3328
#define XB_TOPGEN   3392
#define XCD_BAR_WORDS 3456
#define XB_SPIN_CAP (1u << 18)

__device__ __forceinline__ unsigned xb_ld(unsigned* p)              { return __hip_atomic_load(p, __ATOMIC_RELAXED, __HIP_MEMORY_SCOPE_AGENT); }
__device__ __forceinline__ unsigned xb_add(unsigned* p, unsigned v) { return __hip_atomic_fetch_add(p, v, __ATOMIC_RELAXED, __HIP_MEMORY_SCOPE_AGENT); }
__device__ __forceinline__ unsigned xb_xcc_id() { return (unsigned)__builtin_amdgcn_s_getreg((3 << 11) | 20) & 0xFu; }
#define XB_SPIN(cond, bar) do { unsigned _sp = 0; while (cond) { __builtin_amdgcn_s_sleep(1); \
    if ((++_sp & 255u) == 0u) { if (xb_ld(&(bar)[XB_TMO])) break; if (_sp > XB_SPIN_CAP) { atomicAdd(&(bar)[XB_TMO], 1u); break; } } } } while (0)

struct XcdBarrier {
    unsigned* bar; unsigned x;
    volatile LAS unsigned* st;
};

__device__ __forceinline__ XcdBarrier xcd_barrier_post(unsigned* bar, volatile LAS unsigned* st) {
    XcdBarrier b; b.bar = bar; b.x = xb_xcc_id(); b.st = st;
    if (threadIdx.x == 0) (void)xb_add(&bar[XB_XCNT(b.x)], 1u);
    return b;
}
__device__ __forceinline__ void xcd_barrier_complete(unsigned* bar, unsigned x, unsigned& nloc, unsigned& nx) {
    const unsigned G = gridDim.x * gridDim.y * gridDim.z;
    unsigned sum, cnt, mine, sp = 0u;
    for (;;) {
        sum = 0u; cnt = 0u; mine = 0u;
#pragma unroll
        for (unsigned j = 0; j < 16; ++j) { const unsigned c = xb_ld(&bar[XB_XCNT(j)]); sum += c; cnt += (c > 0u) ? 1u : 0u; mine = (j == x) ? c : mine; }
        if (sum == G) break;
        __builtin_amdgcn_s_sleep(1);
        if ((++sp & 255u) == 0u) { if (xb_ld(&bar[XB_TMO])) break; if (sp > XB_SPIN_CAP) { atomicAdd(&bar[XB_TMO], 1u); break; } }
    }
    nloc = mine > 0u ? mine : 1u; nx = cnt > 0u ? cnt : 1u;
}

__device__ __forceinline__ void xcd_barrier(const XcdBarrier& b) {
    asm volatile("s_waitcnt vmcnt(0)" ::: "memory");
    __syncthreads();
    if (threadIdx.x == 0) {
        unsigned* bar = b.bar;
        __builtin_amdgcn_s_waitcnt(0);
        unsigned nloc = b.st[0], nx = b.st[1];
        if (nloc == 0u) { xcd_barrier_complete(bar, b.x, nloc, nx); b.st[0] = nloc; b.st[1] = nx; }
        const unsigned old = xb_add(&bar[XB_XSUB(b.x)], 1u);
        const unsigned gen = old / nloc;
        if (old + 1u == (gen + 1u) * nloc) {
            __builtin_amdgcn_fence(__ATOMIC_RELEASE, "agent");
            asm volatile("s_waitcnt vmcnt(0)" ::: "memory");
            const unsigned og = xb_add(&bar[XB_TOP], 1u);
            const unsigned tg = og / nx;
            if (og + 1u == (tg + 1u) * nx) xb_add(&bar[XB_TOPGEN], 1u);
            else XB_SPIN(xb_ld(&bar[XB_TOPGEN]) == tg, bar);
            __builtin_amdgcn_fence(__ATOMIC_ACQUIRE, "agent");
            xb_add(&bar[XB_XGEN(b.x)], 1u);
            asm volatile("s_waitcnt vmcnt(0)" ::: "memory");
        } else {
            XB_SPIN(xb_ld(&bar[XB_XGEN(b.x)]) == gen, bar);
            __builtin_amdgcn_fence(__ATOMIC_ACQUIRE, "agent");
            asm volatile("s_waitcnt vmcnt(0)" ::: "memory");
        }
    }
    __syncthreads();
}

constexpr int NPHASE = 9;
__global__ void __launch_bounds__(NTHREADS, 2) fwd_kernel(Args a) {
    extern __shared__ __attribute__((aligned(16))) unsigned char lds_raw[];
    Frame F; F.lds = (LAS unsigned char*)lds_raw; F.tid = threadIdx.x; F.lane = F.tid & 63; F.wave = __builtin_amdgcn_readfirstlane(F.tid >> 6);
    F.G = gridDim.x; { const int bx = blockIdx.x; F.vcu = (F.G % 8 == 0) ? (bx % 8) * (F.G / 8) + bx / 8 : bx; } F.ws = a.ws;
    unsigned char* ws = a.ws;
    const int lo = a.ph_lo, hi = a.ph_hi;
    volatile LAS unsigned* MISC = (volatile LAS unsigned*)(F.lds + MISC_OFF);
    if (F.tid < 64) MISC[F.tid] = 0u;
    __syncthreads();
    XcdBarrier bar; bar.bar = (unsigned*)(ws + WS_CTL + CTL_BAR_OFF); bar.x = 0; bar.st = nullptr;
    if (a.coop) bar = xcd_barrier_post((unsigned*)(ws + WS_CTL + CTL_BAR_OFF), MISC + 8);
#define IN(k) (lo <= (k) && (k) < hi)
#define REFRESH() do { int t_ = threadIdx.x; asm volatile("" : "+v"(t_)); F.tid = t_; F.lane = t_ & 63; F.wave = __builtin_amdgcn_readfirstlane(t_ >> 6); } while (0)
    if (a.coop == 2) cg::this_grid().sync();
#define SEAM(k) do { if (IN(k) && IN((k) + 1)) { xcd_barrier(bar); } } while (0)
    if (IN(0)) { REFRESH(); p0_prologue(F, a); }
    SEAM(0);
    if (IN(1)) {
        if (blockIdx.x >= 128 && blockIdx.x < 160) { REFRESH(); cumsum_block(F, blockIdx.x - 128); }
        SchedDense S; S.A = (const char*)(ws + WS_R1); S.B = (const char*)(ws + WS_WIN_T); S.lda = 1024; S.ldb = 1024; S.nM = T / 256; S.nN = NP1 / 256; S.G = F.G; S.c = blockIdx.x;
        EpiInProj E; E.ws = ws;
        E.nrm = (unsigned*)(ws + WS_CTL + CTL_NRM_OFF); E.G = (unsigned char*)a.out; E.rope = (const float*)(ws + WS_ROPE); E.bgate = (const float*)a.in[5];
        pg8::gemm_phase(F.lds, 1024, S, E);
        if (F.G == 256 && blockIdx.x >= 128) { w2_convert_chunk(F, a, (int)blockIdx.x - 128); __syncthreads(); }
    }
    SEAM(1);
    if (IN(2)) { REFRESH(); p2_attention(F, a); }
    SEAM(2);
    if (IN(3)) {
        SchedDense S; S.A = (const char*)(ws + WS_R1); S.B = (const char*)(ws + WS_WPF_T); S.lda = 1024; S.ldb = 1024; S.nM = T / 256; S.nN = 4; S.G = F.G; S.c = blockIdx.x;
        EpiProjF E; E.M = (bf16_t*)(ws + WS_MERGED); E.G = (const unsigned char*)a.out;
        pg8::gemm_phase(F.lds, 1024, S, E);
    }
    SEAM(3);
    if (IN(4)) {
        SchedDense S; S.A = (const char*)(ws + WS_MERGED); S.B = (const char*)(ws + WS_WOUT_T); S.lda = 1024; S.ldb = 1024; S.nM = T / 256; S.nN = 4; S.G = F.G; S.c = blockIdx.x;
        EpiOut E; E.X = (const float*)a.in[0]; E.O = (bf16_t*)(ws + WS_X1B);
        pg8::gemm_phase(F.lds, 1024, S, E);
    }
    SEAM(4);
    if (IN(5)) { REFRESH(); p5_router(F, a); }
    SEAM(5);
    if (IN(6)) {
        REFRESH(); const MoeTab tb = moe_table(F);
        SchedMoe1 S; S.A = (const char*)(ws + WS_R1); S.B = (const char*)(ws + WS_W13T); S.list = (const int*)(ws + WS_LIST); S.lda = 1024; S.ldb = 1024; S.G = F.G; S.v = F.vcu; S.tb = tb;
        EpiMoe1 E; E.H = (bf16_t*)a.out; E.saL = (const float*)(ws + WS_SAL); E.wsc = (const float*)(ws + WS_WSC);
        pg8::gemm_phase(F.lds, 1024, S, E);
    }
    SEAM(6);
    if (IN(7)) {
        REFRESH(); const MoeTab tb = moe_table(F);
        SchedMoe2 S; S.A = (const char*)a.out; S.B = (const char*)(ws + WS_W2T); S.lda = 512; S.ldb = 512; S.G = F.G; S.v = F.vcu; S.tb = tb;
        EpiMoe2 E; E.Y = (bf16_t*)(ws + WS_YBUF); E.list = (const int*)(ws + WS_LIST); E.gate = (const float*)(ws + WS_GATE);
        pg8::gemm_phase(F.lds, 512, S, E);
    }
    SEAM(7);
    if (IN(8)) { REFRESH(); p8_final(F, a); }
#undef IN
#undef SEAM
}

#ifndef MK_N_LAUNCHES
#define MK_N_LAUNCHES 1
#endif
extern "C" void kernel_launch(void* const* d_in, const int* in_sizes, int n_in, void* d_out, int out_size, void* d_ws, size_t ws_size, hipStream_t stream) {
    static int grid = 0;
    if (grid == 0) {
        if (n_in != 19 || in_sizes[0] != T * DM || out_size != T * DM || ws_size < WS_END) { fprintf(stderr, "kernel_launch: unexpected shapes (n_in %d, in0 %d, out %d, ws %zu < %zu)\n", n_in, n_in > 0 ? in_sizes[0] : -1, out_size, ws_size, (size_t)WS_END); grid = -1; return; }
        int dev = 0, cus = 0, per_cu = 0;
        if (hipGetDevice(&dev) != hipSuccess || hipDeviceGetAttribute(&cus, hipDeviceAttributeMultiprocessorCount, dev) != hipSuccess) { grid = -1; return; }
        if (hipFuncSetAttribute((const void*)fwd_kernel, hipFuncAttributeMaxDynamicSharedMemorySize, LDS_BYTES) != hipSuccess) { fprintf(stderr, "kernel_launch: hipFuncSetAttribute failed\n"); grid = -1; return; }
        if (hipOccupancyMaxActiveBlocksPerMultiprocessor(&per_cu, (const void*)fwd_kernel, NTHREADS, LDS_BYTES) != hipSuccess || per_cu < 1) { fprintf(stderr, "kernel_launch: occupancy query failed (%d)\n", per_cu); (void)hipGetLastError(); grid = -1; return; }
        grid = cus;
    }
    if (grid < 0) return;
    (void)hipMemsetAsync((char*)d_ws + WS_CTL, 0, CTL_ZERO_BYTES, stream);
    Args a{};
    for (int i = 0; i < 19; ++i) a.in[i] = d_in[i];
    a.out = (float*)d_out; a.ws = (unsigned char*)d_ws; a.coop = 0; a.pad = 0;
#if MK_N_LAUNCHES == 1
    a.ph_lo = 0; a.ph_hi = NPHASE; a.coop = 1;
    void* args[] = {&a};
    hipError_t e = hipLaunchCooperativeKernel((const void*)fwd_kernel, dim3(grid), dim3(NTHREADS), args, LDS_BYTES, stream);
    if (e != hipSuccess) fprintf(stderr, "cooperative launch failed: %s (grid %d)\n", hipGetErrorString(e), grid);
#else
    for (int p = 0; p < NPHASE; ++p) { a.ph_lo = p; a.ph_hi = p + 1;
        hipLaunchKernelGGL(fwd_kernel, dim3(grid), dim3(NTHREADS), LDS_BYTES, stream, a); }
#endif
}
```

```cpp
#include <hip/hip_runtime.h>
#include <hip/hip_cooperative_groups.h>
#include <cstdio>
#include <cstdint>
#include <type_traits>
namespace cg = cooperative_groups;

#define LAS __attribute__((address_space(3)))
typedef unsigned short bf16_t;
typedef short bf16x8 __attribute__((ext_vector_type(8)));
typedef short s16x4 __attribute__((ext_vector_type(4)));
typedef float f32x2 __attribute__((ext_vector_type(2)));
typedef float f32x4 __attribute__((ext_vector_type(4)));
typedef float f32x16 __attribute__((ext_vector_type(16)));
typedef unsigned u32x2 __attribute__((ext_vector_type(2)));
typedef unsigned u32x4 __attribute__((ext_vector_type(4)));
typedef int i32x4 __attribute__((ext_vector_type(4)));

constexpr int BATCH = 4, SEQ = 8192, DM = 1024, T = BATCH * SEQ;
constexpr int HD = 64, FOXH = 8, SWAH = 8, SWAKV = 2, WINDOW = 128;
constexpr int NE = 64, DE = 512;
constexpr int N_IN = 4360, NP1 = 4352;
constexpr float EPS = 1e-6f;
constexpr float LOG2E = 1.4426950408889634f;
constexpr float C2 = 0.125f * LOG2E;
constexpr int NWAVES = 8, NTHREADS = 512;

constexpr size_t MiB = 1u << 20;
constexpr size_t WS_CTL = 0, CTL_ZERO_BYTES = 65536, CTL_BAR_OFF = 16384, CTL_NRM_OFF = 32768  , CTL_QUEUE_OFF = 34816  ;
constexpr size_t WS_WIN_T = 1 * MiB;
constexpr size_t WS_WPF_T = 10 * MiB;
constexpr size_t WS_WPS_T = 11 * MiB;
constexpr size_t WS_WOUT_T = 12 * MiB;
constexpr size_t WS_WR = 14 * MiB;
constexpr size_t WS_ROPE = 15 * MiB;
constexpr size_t WS_LOGF = 23 * MiB;
constexpr size_t WS_CUM = 24 * MiB;
constexpr size_t WS_LIST = 25 * MiB;
constexpr size_t WS_GATE = 418 * MiB;
constexpr size_t WS_W13T = 34 * MiB;
constexpr size_t WS_WSC = 9 * MiB + 512 * 1024;
constexpr size_t WS_SAL = 426 * MiB;
constexpr size_t WS_W2T = 162 * MiB;
constexpr size_t WS_R1 = 226 * MiB;
constexpr size_t WS_QF = 290 * MiB, WS_KF = 322 * MiB, WS_VF = 354 * MiB, WS_QS = 386 * MiB, WS_KS = 418 * MiB, WS_VS = 426 * MiB;
constexpr size_t WS_MERGED = 290 * MiB;
constexpr size_t WS_X1B = 354 * MiB;
constexpr size_t WS_YBUF = 226 * MiB;
constexpr size_t WS_END = 434 * MiB;

constexpr int RING_BYTES = 131072;
constexpr int MISC_OFF = RING_BYTES;
constexpr int LDS_BYTES = 147456;

#define LDS_WAIT() asm volatile("s_waitcnt lgkmcnt(0)" ::: "memory")
#define VM_WAIT() asm volatile("s_waitcnt vmcnt(0)" ::: "memory")

__device__ __forceinline__ unsigned f2bf(float f) { unsigned u = __builtin_bit_cast(unsigned, f); return (u + 0x7fffu + ((u >> 16) & 1u)) >> 16; }
__device__ __forceinline__ unsigned pk2(float lo, float hi) { return f2bf(lo) | (f2bf(hi) << 16); }
__device__ __forceinline__ float bf2f(unsigned h) { return __builtin_bit_cast(float, h << 16); }
#define BFLO(w) __builtin_bit_cast(float, (unsigned)(w) << 16)
#define BFHI(w) __builtin_bit_cast(float, (unsigned)(w) & 0xffff0000u)
__device__ __forceinline__ float wave_sum(float v) {
#pragma unroll
    for (int o = 1; o < 64; o <<= 1) v += __shfl_xor(v, o);
    return v;
}
__device__ __forceinline__ float fast_sigmoid(float x) { return __builtin_amdgcn_rcpf(1.0f + __builtin_amdgcn_exp2f(-x * LOG2E)); }

namespace pg8 {
constexpr int BM = 256, BK = 64, HALF = 128, HTB = HALF * BK * 2, STAGE_BYTES = 8 * HTB, NXCD = 8, WGM = 8;
__host__ __device__ __forceinline__ int lds_byte(int r, int c) { const int st = (r >> 4) * 2 + (c >> 5), rr = r & 15, cc = c & 31, ob = rr * 64 + cc * 2; return st * 1024 + (ob ^ (((ob >> 9) & 1) << 5)); }
__host__ __device__ __forceinline__ void stage_rc(int b, int& R, int& C) { const int st = b / 1024, sb = b % 1024, swz = sb ^ (((sb >> 9) & 1) << 5); R = (st >> 1) * 16 + swz / 64; C = (st & 1) * 32 + (swz % 64) / 2; }
__host__ __device__ __forceinline__ int perm32(int rho) { const int n = rho >> 4, i = rho & 15; return 8 * (i >> 2) + 4 * n + (i & 3); }

struct Unit { int pm, pn, e, rows, rowbase, rbg; };

__device__ __forceinline__ bool static_tile(int L, int nM, int nN, int& pm, int& pn) {
    const int nwg = nM * nN; if (L >= nwg) return false;
    int wgid = L; { const int q = nwg / NXCD, r = nwg % NXCD, xcd = wgid % NXCD, off = wgid / NXCD; wgid = (xcd < r ? xcd * (q + 1) : r * (q + 1) + (xcd - r) * q) + off; }
    const int nig = WGM * nN, gid = wgid / nig, fm = gid * WGM, gsz = (nM - fm) < WGM ? (nM - fm) : WGM;
    pm = fm + ((wgid % nig) % gsz); pn = (wgid % nig) / gsz; return true;
}

template <class E, class = void> struct epi_has_mid : std::false_type {};
template <class E> struct epi_has_mid<E, typename std::enable_if<E::HAS_MID>::type> : std::true_type {};
template <class Epi, class Sched>
__device__ __forceinline__ void gemm_phase(LAS unsigned char* lds, const int K, const Sched& S, const Epi& E) {
    const int tid = threadIdx.x, wid = __builtin_amdgcn_readfirstlane(tid >> 6), lane = tid & 63, wr = wid >> 2, wc = wid & 3, fr = lane & 15, fq = lane >> 4;
    constexpr int ES = Sched::ES;
    const int nt = K * ES / (BK * 2);
    unsigned voffB[2]; int RA[2]; unsigned CA2[2];
#pragma unroll
    for (int i = 0; i < 2; ++i) { int R, C; stage_rc(tid * 16 + i * 8192, R, C); const int Rb = (R & ~31) + perm32(R & 31);
        RA[i] = R; CA2[i] = (unsigned)C * 2u; voffB[i] = (unsigned)(Rb * S.ldb * ES) + (unsigned)C * 2u; }
    const size_t kstep = (size_t)(BK * 2);
    const size_t hstepB = (size_t)HALF * S.ldb * ES;
    const unsigned ldsw = (unsigned)wid * 1024u;
    const int aoff = lds_byte(wr * 64 + fr, fq * 8), boff = lds_byte(wc * 32 + fr, fq * 8);
#define PG8_SA(b, h) (((b) * 2 + (h)) * HTB)
#define PG8_SB(b, h) ((4 + (b) * 2 + (h)) * HTB)
#define PG8_STAGE(bufoff, gbase, voff) do { _Pragma("unroll") for (int _i = 0; _i < 2; ++_i) \
        __builtin_amdgcn_global_load_lds((const unsigned*)((const char*)(gbase) + (voff)[_i]), (LAS unsigned*)(lds + (bufoff) + ldsw + _i * 8192), 16, 0, 0); } while (0)
#define PG8_LDA(dst, b, h) do { _Pragma("unroll") for (int m = 0; m < 4; ++m) _Pragma("unroll") for (int k = 0; k < 2; ++k) dst[m][k] = *(const LAS bf16x8*)(lds + PG8_SA(b, h) + aoff + m * 2048 + k * 1024); } while (0)
#define PG8_LDB(dst, b, h) do { _Pragma("unroll") for (int n = 0; n < 2; ++n) _Pragma("unroll") for (int k = 0; k < 2; ++k) dst[n][k] = *(const LAS bf16x8*)(lds + PG8_SB(b, h) + boff + n * 2048 + k * 1024); } while (0)
#define PG8_MMA(ai, bj, At, Bt) do { __builtin_amdgcn_s_setprio(1); _Pragma("unroll") for (int m = 0; m < 4; ++m) _Pragma("unroll") for (int n = 0; n < 2; ++n) _Pragma("unroll") for (int k = 0; k < 2; ++k) { \
        if constexpr (ES == 2) acc[ai][bj][m][n] = __builtin_bit_cast(acc_t, __builtin_amdgcn_mfma_f32_16x16x32_bf16(Bt[n][k], At[m][k], __builtin_bit_cast(f32x4, acc[ai][bj][m][n]), 0, 0, 0)); \
        else acc[ai][bj][m][n] = __builtin_bit_cast(acc_t, __builtin_amdgcn_mfma_i32_16x16x64_i8(__builtin_bit_cast(i32x4, Bt[n][k]), __builtin_bit_cast(i32x4, At[m][k]), __builtin_bit_cast(i32x4, acc[ai][bj][m][n]), 0, 0, 0)); } \
        __builtin_amdgcn_s_setprio(0); } while (0)
#define PG8_WAIT_V(n) asm volatile("s_waitcnt vmcnt(" #n ")" ::: "memory")
#define PG8_WAIT_L(n) asm volatile("s_waitcnt lgkmcnt(" #n ")" ::: "memory")
#define PG8_BAR __builtin_amdgcn_s_barrier()
#define PG8_SCHED __builtin_amdgcn_sched_barrier(0)
    Unit cur, nxt; int ui = 0;
    if (!S.next(0, cur)) return;
    typedef typename Sched::acc_t acc_t;
    acc_t acc[2][2][4][2];
#pragma unroll
    for (int a = 0; a < 2; ++a)
#pragma unroll
        for (int b = 0; b < 2; ++b)
#pragma unroll
            for (int m = 0; m < 4; ++m)
#pragma unroll
                for (int n = 0; n < 2; ++n) acc[a][b][m][n] = acc_t{};
    bf16x8 At[4][2], B0[2][2], B1[2][2];
    const char* cA = S.a_base(cur); const char* cB = S.b_base(cur);
    unsigned offC0[2], offC1[2], offN0[2], offN1[2];
#pragma unroll
    for (int i = 0; i < 2; ++i) { offC0[i] = S.a_off(cur, RA[i]) + CA2[i]; offC1[i] = S.a_off(cur, HALF + RA[i]) + CA2[i]; offN0[i] = offC0[i]; offN1[i] = offC1[i]; }
    PG8_STAGE(PG8_SB(0, 0), cB, voffB); PG8_STAGE(PG8_SB(0, 1), cB + hstepB, voffB); PG8_STAGE(PG8_SA(0, 0), cA, offC0); PG8_STAGE(PG8_SA(0, 1), cA, offC1);
    if (wr == 1) PG8_BAR;
    PG8_WAIT_V(2); PG8_BAR;
    PG8_STAGE(PG8_SB(1, 0), cB + kstep, voffB); PG8_STAGE(PG8_SA(1, 0), cA + kstep, offC0); PG8_STAGE(PG8_SB(1, 1), cB + hstepB + kstep, voffB);
    PG8_WAIT_V(6); PG8_BAR;
    for (;;) {
        const bool has_next = S.next(ui + 1, nxt);
        const char* nA = has_next ? S.a_base(nxt) : cA; const char* nB = has_next ? S.b_base(nxt) : cB;
        if (Sched::GATHER) {
#pragma unroll
            for (int i = 0; i < 2; ++i) { offN0[i] = has_next ? S.a_off(nxt, RA[i]) + CA2[i] : offC0[i]; offN1[i] = has_next ? S.a_off(nxt, HALF + RA[i]) + CA2[i] : offC1[i]; }
        }
        for (int t = 0; t < nt; t += 2) {
            if constexpr (epi_has_mid<Epi>::value) { if (t == (nt >> 1)) E.mid(acc, cur, wr, wc, fr, fq); }
            const bool last = (t == nt - 2);
            const char* a1 = cA + (size_t)(t + 1) * kstep;
            const char* a2 = last ? nA : cA + (size_t)(t + 2) * kstep; const char* b2 = last ? nB : cB + (size_t)(t + 2) * kstep;
            const char* a3 = a2 + kstep; const char* b3 = b2 + kstep;
            unsigned o20[2], o21[2];
#pragma unroll
            for (int i = 0; i < 2; ++i) { o20[i] = (Sched::GATHER && last) ? offN0[i] : offC0[i]; o21[i] = (Sched::GATHER && last) ? offN1[i] : offC1[i]; }
            PG8_LDB(B0, 0, 0); PG8_LDB(B1, 0, 1); PG8_SCHED; PG8_LDA(At, 0, 0); PG8_STAGE(PG8_SA(1, 1), a1, offC1);
            PG8_WAIT_V(8); PG8_WAIT_L(0); PG8_BAR; PG8_MMA(0, 0, At, B0); PG8_MMA(0, 1, At, B1); PG8_BAR; PG8_SCHED;
            PG8_LDA(At, 0, 1); PG8_STAGE(PG8_SB(0, 0), b2, voffB); PG8_STAGE(PG8_SB(0, 1), b2 + hstepB, voffB); PG8_STAGE(PG8_SA(0, 0), a2, o20);
            PG8_WAIT_V(8); PG8_WAIT_L(0); PG8_BAR; PG8_MMA(1, 0, At, B0); PG8_MMA(1, 1, At, B1); PG8_BAR; PG8_SCHED;
            PG8_LDB(B0, 1, 0); PG8_LDB(B1, 1, 1); PG8_SCHED; PG8_LDA(At, 1, 0); PG8_STAGE(PG8_SA(0, 1), a2, o21);
            PG8_WAIT_V(8); PG8_WAIT_L(0); PG8_BAR; PG8_MMA(0, 0, At, B0); PG8_MMA(0, 1, At, B1); PG8_BAR; PG8_SCHED;
            PG8_LDA(At, 1, 1); PG8_STAGE(PG8_SB(1, 0), b3, voffB); PG8_STAGE(PG8_SB(1, 1), b3 + hstepB, voffB); PG8_STAGE(PG8_SA(1, 0), a3, o20);
            PG8_WAIT_V(8); PG8_WAIT_L(0); PG8_BAR; PG8_MMA(1, 0, At, B0); PG8_MMA(1, 1, At, B1); PG8_BAR; PG8_SCHED;
        }
        if (wr == 0) PG8_BAR;
        E(acc, cur, wr, wc, fr, fq);
        if (!has_next) break;
#pragma unroll
        for (int a = 0; a < 2; ++a)
#pragma unroll
            for (int b = 0; b < 2; ++b)
#pragma unroll
                for (int m = 0; m < 4; ++m)
#pragma unroll
                    for (int n = 0; n < 2; ++n) acc[a][b][m][n] = acc_t{};
        cur = nxt; cA = nA; cB = nB; ++ui;
        if (Sched::GATHER) {
#pragma unroll
            for (int i = 0; i < 2; ++i) { offC0[i] = offN0[i]; offC1[i] = offN1[i]; }
        }
        if (wr == 1) PG8_BAR;
    }
    PG8_WAIT_V(0);
    PG8_BAR;
#undef PG8_SA
#undef PG8_SB
#undef PG8_STAGE
#undef PG8_LDA
#undef PG8_LDB
#undef PG8_MMA
#undef PG8_WAIT_V
#undef PG8_WAIT_L
#undef PG8_BAR
#undef PG8_SCHED
}
}
using pg8::Unit;

#include <hip/hip_bf16.h>
namespace attn_body {
using bf16=__hip_bfloat16;
using bf16x8=__attribute__((ext_vector_type(8)))short;
using s16x4=__attribute__((ext_vector_type(4)))short;
using f32x16=__attribute__((ext_vector_type(16)))float;
using u32x4=__attribute__((ext_vector_type(4)))unsigned;
constexpr int BATCH=4,NHEAD=8,SEQ=8192,D=64,DM=NHEAD*D;
constexpr int NW=8,QBLK=32,QB=QBLK*NW,KVBLK=64,NQB=SEQ/QB;
constexpr int ATTN_PITCH=DM, ATTN_UNIT_ROWS=QB;
__device__ __forceinline__ int crow(int r,int hi){return (r&3)+8*(r>>2)+4*hi;}
#define SBAR() __builtin_amdgcn_sched_barrier(0)
__device__ __forceinline__ void cmask(f32x16&p0,f32x16&p1,int jb,int qrel,int hi){
  const float NEG=-INFINITY; int kb=64*jb+4*hi;
  #pragma unroll
  for(int r=0;r<16;++r){int kv=kb+(r&3)+8*(r>>2); if(kv>qrel)p0[r]=NEG; if(kv+32>qrel)p1[r]=NEG;}
}

constexpr int NSLOT=3, SLOTB=8192;
constexpr int LDS_K=0, LDS_V=NSLOT*SLOTB, LDS_WS=2*NSLOT*SLOTB, LDS_OST=LDS_WS+NW*64*4, LDS_CS=LDS_OST+NW*4096, LDS_BYTES=LDS_CS+SEQ*4;
constexpr float C2=0.125f*1.4426950408889634f;
__device__ __forceinline__ void glds16(const void*gsrc,unsigned lds_dst){unsigned keep;
  asm volatile("s_mov_b32 %0, m0\n\ts_mov_b32 m0, %2\n\ts_nop 0\n\tglobal_load_lds_dwordx4 %1, off\n\ts_mov_b32 m0, %0":"=&s"(keep):"v"(gsrc),"s"(lds_dst):"memory");}
__device__ __forceinline__ float max3f(float a,float b,float c){float r;asm("v_max3_f32 %0, %1, %2, %3":"=v"(r):"v"(a),"v"(b),"v"(c));return r;}
__device__ __forceinline__ float max2f(float a,float b){float r;asm("v_max_f32_e32 %0, %1, %2":"=v"(r):"v"(a),"v"(b));return r;}
__device__ __forceinline__ float fadd_s(float a,float b){float r;asm("v_add_f32_e32 %0, %1, %2":"=v"(r):"v"(a),"v"(b));return r;}
__device__ __forceinline__ float fsub_s(float a,float b){float r;asm("v_sub_f32_e32 %0, %1, %2":"=v"(r):"v"(a),"v"(b));return r;}
typedef float f32x2_t __attribute__((ext_vector_type(2))); typedef __bf16 bf16x2_t __attribute__((ext_vector_type(2)));
__device__ __forceinline__ unsigned cvtpk_s(float lo,float hi){f32x2_t v={lo,hi};bf16x2_t b=__builtin_convertvector(v,bf16x2_t);return __builtin_bit_cast(unsigned,b);}
#define WAIT_BAR(N) asm volatile("s_waitcnt vmcnt(" #N ") lgkmcnt(0)\n\ts_barrier":::"memory")

__device__ __forceinline__ void qkt(f32x16&p0,f32x16&p1,const char*Kslot,const bf16x8*qr,const f32x16&c0,const f32x16&c1,int r32,int hi){
  const char*kb=Kslot+hi*1024+r32*16;
  #pragma unroll
  for(int d0=0;d0<4;++d0){
    const bf16x8 b0=*reinterpret_cast<const bf16x8*>(kb+d0*2048);
    const bf16x8 b1=*reinterpret_cast<const bf16x8*>(kb+d0*2048+512);
    if(d0==0){p0=__builtin_amdgcn_mfma_f32_32x32x16_bf16(b0,qr[0],c0,0,0,0);p1=__builtin_amdgcn_mfma_f32_32x32x16_bf16(b1,qr[0],c1,0,0,0);}
    else{p0=__builtin_amdgcn_mfma_f32_32x32x16_bf16(b0,qr[d0],p0,0,0,0);p1=__builtin_amdgcn_mfma_f32_32x32x16_bf16(b1,qr[d0],p1,0,0,0);}}
}
typedef __attribute__((address_space(3))) const char* lds_cptr;
typedef short v4i16_t __attribute__((ext_vector_type(4)));
__device__ __forceinline__ void kload8(bf16x8*kf,lds_cptr kp){
  kf[0]=*(const __attribute__((address_space(3))) bf16x8*)(kp);      kf[1]=*(const __attribute__((address_space(3))) bf16x8*)(kp+512);
  kf[2]=*(const __attribute__((address_space(3))) bf16x8*)(kp+2048); kf[3]=*(const __attribute__((address_space(3))) bf16x8*)(kp+2560);
  kf[4]=*(const __attribute__((address_space(3))) bf16x8*)(kp+4096); kf[5]=*(const __attribute__((address_space(3))) bf16x8*)(kp+4608);
  kf[6]=*(const __attribute__((address_space(3))) bf16x8*)(kp+6144); kf[7]=*(const __attribute__((address_space(3))) bf16x8*)(kp+6656);
}
__device__ __forceinline__ void kload2(bf16x8*kf,lds_cptr kp,int j){ kf[2*j]=*(const __attribute__((address_space(3))) bf16x8*)(kp+j*2048); kf[2*j+1]=*(const __attribute__((address_space(3))) bf16x8*)(kp+j*2048+512); }
__device__ __forceinline__ s16x4 vtr(lds_cptr p){ return __builtin_bit_cast(s16x4,__builtin_amdgcn_ds_read_tr16_b64_v4i16((__attribute__((address_space(3))) v4i16_t*)p)); }
__device__ __forceinline__ float rowmax(const f32x16&p0,const f32x16&p1){
  float a=max3f(p0[0],p0[1],p1[0]),b=max3f(p0[2],p0[3],p1[1]);a=max3f(a,p1[2],p1[3]);
  #pragma unroll
  for(int r=4;r<16;r+=4){a=max3f(a,p0[r],p0[r+1]);b=max3f(b,p0[r+2],p0[r+3]);a=max3f(a,p1[r],p1[r+1]);b=max3f(b,p1[r+2],p1[r+3]);}
  const float m=max2f(a,b);
  auto rr=__builtin_amdgcn_permlane32_swap(__float_as_uint(m),__float_as_uint(m),false,false);
  return max2f(__uint_as_float(rr[0]),__uint_as_float(rr[1]));
}
__device__ __forceinline__ void pv(f32x16*o,int vb,bf16x8 pa0,bf16x8 pa1,bf16x8 pa2,bf16x8 pa3){
  #pragma unroll
  for(int d0=0;d0<2;++d0){s16x4 lo[4],hi[4];
    #pragma unroll
    for(int ks=0;ks<4;++ks){
      asm volatile("ds_read_b64_tr_b16 %0,%1 offset:%c2":"=&v"(lo[ks]):"v"(vb),"i"(d0*4096+ks*1024):"memory");
      asm volatile("ds_read_b64_tr_b16 %0,%1 offset:%c2":"=&v"(hi[ks]):"v"(vb),"i"(d0*4096+ks*1024+512):"memory");}
    asm volatile("s_waitcnt lgkmcnt(0)":::"memory");SBAR();
    #define PK(k) (bf16x8){lo[k][0],lo[k][1],lo[k][2],lo[k][3],hi[k][0],hi[k][1],hi[k][2],hi[k][3]}
    o[d0]=__builtin_amdgcn_mfma_f32_32x32x16_bf16(pa0,PK(0),o[d0],0,0,0);
    o[d0]=__builtin_amdgcn_mfma_f32_32x32x16_bf16(pa1,PK(1),o[d0],0,0,0);
    o[d0]=__builtin_amdgcn_mfma_f32_32x32x16_bf16(pa2,PK(2),o[d0],0,0,0);
    o[d0]=__builtin_amdgcn_mfma_f32_32x32x16_bf16(pa3,PK(3),o[d0],0,0,0);
    #undef PK
  }
}

#ifndef ATTN_STORE16
#define ATTN_STORE16(p,v) (*(u32x4*)(p)=(v))
#endif
template<int THRL> __device__ __forceinline__ void attn_unit(int b,int h,int qb,const bf16*Q,const bf16*__restrict__ K,const bf16*__restrict__ V,bf16*O,const float*__restrict__ cum,const unsigned*__restrict__ nrm,char*shm){
  const int tid=threadIdx.x,lane=tid&63,r32=lane&31,hi=lane>>5; const int wid=__builtin_amdgcn_readfirstlane(tid>>6);
  const long rowbase=(long)b*SEQ; const int q0=qb*QB;
  const bf16*Qw=Q+(rowbase+q0+wid*QBLK)*DM+h*D;
  const float*crow_=cum+(long)b*NHEAD*SEQ+(long)h*SEQ;
  int jst;
  { const int bh2=(b*NHEAD+h)*2;
    const float qs=__uint_as_float(nrm[bh2])+__uint_as_float(nrm[bh2+1]), ks=__uint_as_float(nrm[128+bh2])+__uint_as_float(nrm[128+bh2+1]);
    constexpr float SKIP_LOG2=64.0f; const float Tthr=SKIP_LOG2+2.04f*__builtin_sqrtf(qs*ks);
    const float cq0=crow_[q0]; const int NTF=(q0+QB)/KVBLK; const int j1=lane+1,j2=lane+65;
    const bool c1=(j1<=NTF-4)&&(cq0-crow_[64*(j1<=NTF-4?j1:1)-1]<-Tthr), c2=(j2<=NTF-4)&&(cq0-crow_[64*(j2<=NTF-4?j2:1)-1]<-Tthr);
    jst=__builtin_amdgcn_readfirstlane((__popcll(__ballot(c1))+__popcll(__ballot(c2)))&~1); }
  const bf16*Kh=K+(rowbase+(long)jst*KVBLK)*DM+h*D,*Vh=V+(rowbase+(long)jst*KVBLK)*DM+h*D;
  const unsigned lds0=(unsigned)(uintptr_t)shm;
  float*wsf=(float*)(shm+LDS_WS)+wid*64;
  const bf16*ksrc=Kh+(long)lane*DM+wid*8;
  const bf16*vsrc=Vh+(long)(16*(wid&3)+(lane>>2))*DM+(wid>>2)*32+(lane&3)*8;
  const unsigned kdst=lds0+LDS_K+wid*1024, vdst=lds0+LDS_V+wid*1024;
  #define DMA_K(t,slot) glds16(ksrc+(long)(t)*KVBLK*DM,(unsigned)__builtin_amdgcn_readfirstlane(kdst+(slot)))
  #define DMA_V(t,slot) glds16(vsrc+(long)(t)*KVBLK*DM,(unsigned)__builtin_amdgcn_readfirstlane(vdst+(slot)))
  const int vb0=(int)(lds0+LDS_V)+((lane>>4)&1)*32+(lane&3)*8+(4*hi+((lane&15)>>2))*64;
  const char*Kbase=shm+LDS_K; bf16x8 kf[8];
  const lds_cptr shm3=(lds_cptr)shm; const lds_cptr kp0=shm3+LDS_K+hi*1024+r32*16; const lds_cptr vp0=shm3+LDS_V+((lane>>4)&1)*32+(lane&3)*8+(4*hi+((lane&15)>>2))*64;
  const int NT=(q0+QB)/KVBLK-jst;
  { for(int p=(jst>>2)+wid;p<=qb;p+=NW) glds16(crow_+p*256+lane*4,(unsigned)__builtin_amdgcn_readfirstlane(lds0+LDS_CS+p*1024)); }
  const float ctq=crow_[q0+wid*QBLK+r32];
  const float*csl=(const float*)(shm+LDS_CS)+jst*KVBLK;
  DMA_K(0,0);DMA_V(0,0);DMA_K(1,SLOTB);
  bf16x8 qr[4];
  #pragma unroll
  for(int d0=0;d0<4;++d0)qr[d0]=*reinterpret_cast<const bf16x8*>(&Qw[(long)r32*DM+d0*16+hi*8]);
  float l_reg=0.f;f32x16 o[2];o[0]=f32x16{};o[1]=f32x16{};const f32x16 zero16=f32x16{};
  float bq=hi?ctq:-1.0f;
  #define BQ_UPDATE(dl_) do{ bq=hi?(bq-(dl_)):-1.0f; }while(0)
  #define BIAS(C0,C1,t) do{ const float a0_=hi?1.0f:csl[(t)*64+r32]; const float a1_=hi?1.0f:csl[(t)*64+32+r32]; \
      C0=__builtin_amdgcn_mfma_f32_32x32x2f32(a0_,bq,zero16,0,0,0); C1=__builtin_amdgcn_mfma_f32_32x32x2f32(a1_,bq,zero16,0,0,0); }while(0)
  const int qrel=wid*QBLK+r32;
  #define CMASK(P0,P1,t) do{int jb_=(t)-(NT-4); if(jb_>=0)cmask(P0,P1,jb_,qrel,hi);}while(0)
  bool resc=false;
  #define START(P0,P1) do{ const float rm=rowmax(P0,P1); resc=false; \
    { const float dl=rm; \
      _Pragma("unroll") for(int r=0;r<16;++r){P0[r]=fsub_s(P0[r],dl);P1[r]=fsub_s(P1[r],dl);} \
      BQ_UPDATE(dl); } \
    _Pragma("unroll") for(int r=0;r<16;++r)P0[r]=__builtin_amdgcn_exp2f(P0[r]); }while(0)
  #define RESC() do{ if(resc){ asm volatile("s_waitcnt lgkmcnt(0)":::"memory"); \
      _Pragma("unroll") for(int d_=0;d_<2;++d_) _Pragma("unroll") for(int r=0;r<16;++r)o[d_][r]*=wsf[crow(r,hi)]; } }while(0)
  f32x16 pA0,pA1,pB0,pB1;
  int sl_prev=0,sl_cur=0,sl_next=SLOTB;
  #define ROT() do{sl_prev=sl_cur;sl_cur=sl_next;sl_next=(sl_next==(NSLOT-1)*SLOTB)?0:sl_next+SLOTB;}while(0)
  DMA_K(2,2*SLOTB);
  WAIT_BAR(3);
  { f32x16 cb0,cb1; BIAS(cb0,cb1,0); qkt(pA0,pA1,Kbase,qr,cb0,cb1,r32,hi); } asm volatile("s_nop 15\n\ts_nop 7":"+v"(pA0),"+v"(pA1));CMASK(pA0,pA1,0);
  START(pA0,pA1);
  _Pragma("unroll") for(int r=0;r<16;++r)pA1[r]=__builtin_amdgcn_exp2f(pA1[r]);
  WAIT_BAR(0);
  DMA_K(3,0);DMA_V(1,SLOTB);
  ROT();
  kload8(kf,kp0+sl_cur);
  WAIT_BAR(2);
  s16x4 vlo[8],vhi[8]; u32x4 pw0,pw1,pw2,pw3;
  #define PKW(P,B) cvtpk_s(P[B],P[B+1])
  #define PAF(k) __builtin_bit_cast(bf16x8,pw##k)
  #define VFR(i) (bf16x8){vlo[i][0],vlo[i][1],vlo[i][2],vlo[i][3],vhi[i][0],vhi[i][1],vhi[i][2],vhi[i][3]}
  #define PIN(x) asm volatile("":"+v"(x))
  #define MX3(a,b,c) __builtin_fmaxf(__builtin_fmaxf((a),(b)),(c))
  #define GAPA(MF,A0,A1,A2,A3,W0,W1,PW) do{ MF; sacc+=A0; sacc+=A1; sacc+=A2; sacc+=A3; PIN(sacc); W0; W1; PIN(PW); SBAR(); }while(0)
  #define EX(v) __builtin_amdgcn_exp2f(v)
  #define GAPB(MF,X,B) do{ MF; X[B]=EX(X[B]); X[B+1]=EX(X[B+1]); X[B+2]=EX(X[B+2]); X[B+3]=EX(X[B+3]); PIN(X); SBAR(); }while(0)
  #define VRD(i) do{ vlo[i]=vtr(vp_+(((i)>>2)*4096+((i)&3)*1024)); vhi[i]=vtr(vp_+(((i)>>2)*4096+((i)&3)*1024+512)); }while(0)
  #define KRD(G,j) do{ if(G){ kload2(kf,kp0+sl_next,j); SBAR(); } }while(0)
  #define STEP(C0,C1,P0,P1,t,GK,GV,GL) do{ SBAR(); \
    BIAS(C0,C1,t); SBAR(); \
    const lds_cptr vp_=vp0+sl_prev; \
    VRD(0); SBAR(); float sacc=(P0[0]+P0[1]); \
    GAPA(C0=__builtin_amdgcn_mfma_f32_32x32x16_bf16(kf[0],qr[0],C0,0,0,0), P0[2],P0[3],P0[4],P0[5],     pw0[0]=PKW(P0,0), pw0[1]=PKW(P0,2), pw0); \
    VRD(4); SBAR(); GAPA(C1=__builtin_amdgcn_mfma_f32_32x32x16_bf16(kf[1],qr[0],C1,0,0,0), P0[6],P0[7],P0[8],P0[9],     pw0[2]=PKW(P0,4), pw0[3]=PKW(P0,6), pw0); \
    VRD(1); SBAR(); GAPA(C0=__builtin_amdgcn_mfma_f32_32x32x16_bf16(kf[2],qr[1],C0,0,0,0),   P0[10],P0[11],P0[12],P0[13], pw1[0]=PKW(P0,8), pw1[1]=PKW(P0,10), pw1); \
    VRD(5); SBAR(); GAPA(C1=__builtin_amdgcn_mfma_f32_32x32x16_bf16(kf[3],qr[1],C1,0,0,0),   P0[14],P0[15],P1[0],P1[1],   pw1[2]=PKW(P0,12),pw1[3]=PKW(P0,14), pw1); \
    VRD(2); SBAR(); GAPA(C0=__builtin_amdgcn_mfma_f32_32x32x16_bf16(kf[4],qr[2],C0,0,0,0),   P1[2],P1[3],P1[4],P1[5],     pw2[0]=PKW(P1,0), pw2[1]=PKW(P1,2), pw2); \
    VRD(6); SBAR(); GAPA(C1=__builtin_amdgcn_mfma_f32_32x32x16_bf16(kf[5],qr[2],C1,0,0,0),   P1[6],P1[7],P1[8],P1[9],     pw2[2]=PKW(P1,4), pw2[3]=PKW(P1,6), pw2); \
    VRD(3); SBAR(); GAPA(C0=__builtin_amdgcn_mfma_f32_32x32x16_bf16(kf[6],qr[3],C0,0,0,0),   P1[10],P1[11],P1[12],P1[13], pw3[0]=PKW(P1,8), pw3[1]=PKW(P1,10), pw3); \
    VRD(7); SBAR(); GAPA(C1=__builtin_amdgcn_mfma_f32_32x32x16_bf16(kf[7],qr[3],C1,0,0,0),   P1[14],P1[15],0.f,0.f,       pw3[2]=PKW(P1,12),pw3[3]=PKW(P1,14), pw3); \
    l_reg+=sacc; \
    if(GK){DMA_K((t)+3,sl_cur);} if(GV){DMA_V((t)+1,sl_next);} \
    CMASK(C0,C1,t); \
    { float a=MX3(C0[0],C0[1],C1[0]),b=MX3(C0[2],C0[3],C1[1]); a=MX3(a,C1[2],C1[3]); \
      _Pragma("unroll") for(int r=4;r<16;r+=4){a=MX3(a,C0[r],C0[r+1]);b=MX3(b,C0[r+2],C0[r+3]);a=MX3(a,C1[r],C1[r+1]);b=MX3(b,C1[r+2],C1[r+3]);} \
      float rm=__builtin_fmaxf(a,b); { auto rr=__builtin_amdgcn_permlane32_swap(__float_as_uint(rm),__float_as_uint(rm),false,false); rm=__builtin_fmaxf(__uint_as_float(rr[0]),__uint_as_float(rr[1])); } \
      resc=false; \
      if(__builtin_expect(__any(rm>(float)THRL),0)){ const float dl=__builtin_fmaxf(rm,0.f); \
        _Pragma("unroll") for(int r=0;r<16;++r){C0[r]-=dl;C1[r]-=dl;} \
        BQ_UPDATE(dl); \
        const float f=__builtin_amdgcn_exp2f(-dl); l_reg*=f; if(hi==0)wsf[r32]=f; resc=true; } } \
    SBAR(); \
    GAPB(o[0]=__builtin_amdgcn_mfma_f32_32x32x16_bf16(PAF(0),VFR(0),o[0],0,0,0), C0,0); \
    GAPB(o[1]=__builtin_amdgcn_mfma_f32_32x32x16_bf16(PAF(0),VFR(4),o[1],0,0,0), C0,4); \
    KRD(GL,0); GAPB(o[0]=__builtin_amdgcn_mfma_f32_32x32x16_bf16(PAF(1),VFR(1),o[0],0,0,0), C0,8); \
    KRD(GL,1); GAPB(o[1]=__builtin_amdgcn_mfma_f32_32x32x16_bf16(PAF(1),VFR(5),o[1],0,0,0), C0,12); \
    KRD(GL,2); GAPB(o[0]=__builtin_amdgcn_mfma_f32_32x32x16_bf16(PAF(2),VFR(2),o[0],0,0,0), C1,0); \
    KRD(GL,3); GAPB(o[1]=__builtin_amdgcn_mfma_f32_32x32x16_bf16(PAF(2),VFR(6),o[1],0,0,0), C1,4); \
    GAPB(o[0]=__builtin_amdgcn_mfma_f32_32x32x16_bf16(PAF(3),VFR(3),o[0],0,0,0), C1,8); \
    GAPB(o[1]=__builtin_amdgcn_mfma_f32_32x32x16_bf16(PAF(3),VFR(7),o[1],0,0,0), C1,12); \
    }while(0)
  int t=1;
  #undef CMASK
  #define CMASK(P0,P1,t) do{}while(0)
  for(;t+5<NT;t+=2){
    STEP(pB0,pB1,pA0,pA1,t,true,true,true);     WAIT_BAR(2); RESC(); ROT();
    STEP(pA0,pA1,pB0,pB1,t+1,true,true,true);   WAIT_BAR(2); RESC(); ROT();
  }
  #undef CMASK
  #define CMASK(P0,P1,t) do{int jb_=(t)-(NT-4); if(jb_>=0)cmask(P0,P1,jb_,qrel,hi);}while(0)
  #define ENDW(tt) do{ if((tt)+3<NT){WAIT_BAR(2);} else if((tt)+2<NT){WAIT_BAR(1);} else {WAIT_BAR(0);} }while(0)
  for(;t+1<NT;t+=2){
    STEP(pB0,pB1,pA0,pA1,t,(t+3<NT),(t+1<NT),(t+1<NT));       ENDW(t);   RESC(); ROT();
    STEP(pA0,pA1,pB0,pB1,t+1,(t+4<NT),(t+2<NT),(t+2<NT));     ENDW(t+1); RESC(); ROT();
  }
  STEP(pB0,pB1,pA0,pA1,NT-1,false,false,false); RESC();
  { float sacc=pB0[0]+pB0[1]; _Pragma("unroll") for(int r=2;r<16;++r)sacc+=pB0[r]; _Pragma("unroll") for(int r=0;r<16;++r)sacc+=pB1[r]; l_reg+=sacc;
    pw0=(u32x4){PKW(pB0,0),PKW(pB0,2),PKW(pB0,4),PKW(pB0,6)};pw1=(u32x4){PKW(pB0,8),PKW(pB0,10),PKW(pB0,12),PKW(pB0,14)};pw2=(u32x4){PKW(pB1,0),PKW(pB1,2),PKW(pB1,4),PKW(pB1,6)};pw3=(u32x4){PKW(pB1,8),PKW(pB1,10),PKW(pB1,12),PKW(pB1,14)};
    SBAR(); pv(o,vb0+sl_cur,PAF(0),PAF(1),PAF(2),PAF(3)); }
  #undef PKW
  #undef PAF
  #undef VFR
  #undef PIN
  #undef MX3
  #undef GAPA
  #undef GAPB
  #undef EX
  #undef VRD
  #undef KRD
  #undef STEP
  #undef ENDW
  {auto rr=__builtin_amdgcn_permlane32_swap(__float_as_uint(l_reg),__float_as_uint(l_reg),false,false);l_reg=__uint_as_float(rr[0])+__uint_as_float(rr[1]);}
  if(hi==0)wsf[32+r32]=l_reg;asm volatile("s_waitcnt lgkmcnt(0)":::"memory");
  float rli[16];
  #pragma unroll
  for(int r=0;r<16;++r)rli[r]=__builtin_amdgcn_rcpf(wsf[32+crow(r,hi)]);
  constexpr int OPITCH=2*DM;
  bf16*Ow=O+(rowbase+q0+wid*QBLK)*OPITCH+h*D;
  { bf16*stg=(bf16*)(shm+LDS_OST)+wid*2048;
    #pragma unroll
    for(int r=0;r<16;++r){const int orow=crow(r,hi);
      #pragma unroll
      for(int d0=0;d0<2;++d0)stg[orow*64+d0*32+r32]=__float2bfloat16(o[d0][r]*rli[r]);}
    asm volatile("s_waitcnt lgkmcnt(0)":::"memory");
    #pragma unroll
    for(int i=0;i<4;++i){const int row=i*8+(lane>>3),ch=lane&7; const u32x4 v=*(const u32x4*)(stg+row*64+ch*8); ATTN_STORE16(Ow+(long)row*OPITCH+ch*8,v);} }
  asm volatile("s_waitcnt lgkmcnt(0)\n\ts_barrier":::"memory");
  #undef DMA_K
  #undef DMA_V
  #undef CMASK
  #undef START
  #undef RESC
  #undef ROT
  #undef BIAS
  #undef BQ_UPDATE
}
constexpr int ATTN_LDS_BYTES=LDS_BYTES;
struct AttnTensors { const bf16* Q; const bf16* K; const bf16* V; bf16* O; const float* cum; };
struct AttnUnit { int bh; int qb; };
struct StaticOrder {
  int vcu;
  __device__ __forceinline__ explicit StaticOrder(int grid,int block):vcu((block%8)*(grid/8)+block/8){}
  __device__ __forceinline__ bool next(int i,AttnUnit&u)const{ if(i>=4)return false; const int s=vcu&7; u.bh=vcu>>3; u.qb=(i==0)?s:(i==1)?15-s:(i==2)?16+s:31-s; return true; }
  __device__ __forceinline__ void a_ready(const AttnUnit&)const{}
  __device__ __forceinline__ void done(const AttnUnit&)const{}
};
template<class Sched,int THRL=8> __device__ __forceinline__ void attn_phase(char*lds,const AttnTensors&T,const Sched&S){
  AttnUnit u;
  for(int i=0;S.next(i,u);++i){ S.a_ready(u); attn_unit<THRL>(u.bh/NHEAD,u.bh%NHEAD,u.qb,T.Q,T.K,T.V,T.O,T.cum,lds); S.done(u); }
}
#undef SBAR
#undef WAIT_BAR
}

__device__ __forceinline__ unsigned cvt_pk_bf16(float lo, float hi) {
    typedef __bf16 bf16x2_t __attribute__((ext_vector_type(2)));
    f32x2 v = {lo, hi}; bf16x2_t b = __builtin_convertvector(v, bf16x2_t); return __builtin_bit_cast(unsigned, b);
}
__device__ __forceinline__ u32x4 pack8(const f32x4 a, const f32x4 b) { u32x4 w; w.x = cvt_pk_bf16(a[0], a[1]); w.y = cvt_pk_bf16(a[2], a[3]); w.z = cvt_pk_bf16(b[0], b[1]); w.w = cvt_pk_bf16(b[2], b[3]); return w; }
__device__ __forceinline__ u32x2 pack4(const f32x4 a) { u32x2 w; w.x = cvt_pk_bf16(a[0], a[1]); w.y = cvt_pk_bf16(a[2], a[3]); return w; }

struct SchedDense {
    static constexpr bool GATHER = false; static constexpr int ES = 2; typedef f32x4 acc_t;
    const char* A; const char* B; int lda, ldb, nM, nN, G, c;
    __device__ __forceinline__ bool next(int i, Unit& u) const { u.e = 0; u.rows = 256; u.rowbase = 0; u.rbg = 0; return pg8::static_tile(i * G + c, nM, nN, u.pm, u.pn); }
    __device__ __forceinline__ const char* a_base(const Unit& u) const { return A + (size_t)u.pm * 256 * lda * 2; }
    __device__ __forceinline__ const char* b_base(const Unit& u) const { return B + (size_t)u.pn * 256 * ldb * 2; }
    __device__ __forceinline__ unsigned a_off(const Unit&, int R) const { return (unsigned)(R * lda) * 2u; }
};
struct SchedProj {
    static constexpr bool GATHER = false; static constexpr int ES = 2; typedef f32x4 acc_t;
    const char* A0; const char* B0; size_t dA, dB; int lda, ldb, nM, nN, G, c;
    __device__ __forceinline__ bool next(int i, Unit& u) const { u.e = i & 1; u.rows = 256; u.rowbase = 0; u.rbg = 0; return pg8::static_tile((i >> 1) * G + c, nM, nN, u.pm, u.pn); }
    __device__ __forceinline__ const char* a_base(const Unit& u) const { return A0 + (size_t)u.e * dA + (size_t)u.pm * 256 * lda * 2; }
    __device__ __forceinline__ const char* b_base(const Unit& u) const { return B0 + (size_t)u.e * dB + (size_t)u.pn * 256 * ldb * 2; }
    __device__ __forceinline__ unsigned a_off(const Unit&, int R) const { return (unsigned)(R * lda) * 2u; }
};
struct MoeTab { const LAS int* pre; const LAS int* cnt; };
__device__ __forceinline__ bool moe_unit(const MoeTab& tb, int L, Unit& u) {
    const int nrb = tb.pre[NE];
    if (L >= nrb * 4) return false;
    const int rbg = L >> 2; u.pn = L & 3; u.rbg = rbg;
    int lo = 0, hi = NE - 1;
#pragma unroll 1
    while (lo < hi) { const int mid = (lo + hi + 1) >> 1; if (tb.pre[mid] <= rbg) lo = mid; else hi = mid - 1; }
#pragma unroll 1
    while (tb.pre[lo + 1] <= rbg) ++lo;
    const int rb = rbg - tb.pre[lo];
    u.e = lo; u.pm = rb; const int left = tb.cnt[lo] - rb * 256; u.rows = left < 256 ? left : 256; u.rowbase = lo * T + rb * 256;
    return true;
}
struct SchedMoe1 {
    static constexpr bool GATHER = true; static constexpr int ES = 1; typedef i32x4 acc_t;
    const char* A; const char* B; const int* list; int lda, ldb, G, v; MoeTab tb;
    __device__ __forceinline__ bool next(int i, Unit& u) const { return moe_unit(tb, i * G + v, u); }
    __device__ __forceinline__ const char* a_base(const Unit&) const { return A; }
    __device__ __forceinline__ const char* b_base(const Unit& u) const { return B + ((size_t)u.e * 1024 + (size_t)u.pn * 256) * ldb; }
    __device__ __forceinline__ unsigned a_off(const Unit& u, int R) const { const int id = (R < u.rows) ? list[u.rowbase + R] : 0; return (unsigned)(id >> 1) * (unsigned)lda; }
};
struct SchedMoe2 {
    static constexpr int ES = 2; typedef f32x4 acc_t;
    static constexpr bool GATHER = true;
    const char* A; const char* B; int lda, ldb, G, v; MoeTab tb;
    __device__ __forceinline__ bool next(int i, Unit& u) const { return moe_unit(tb, i * G + v, u); }
    __device__ __forceinline__ const char* a_base(const Unit& u) const { return A + (size_t)u.rbg * 256 * lda * 2; }
    __device__ __forceinline__ const char* b_base(const Unit& u) const { return B + ((size_t)u.e * 1024 + (size_t)u.pn * 256) * ldb * 2; }
    __device__ __forceinline__ unsigned a_off(const Unit&, int R) const { return (unsigned)(R * lda) * 2u; }
};

struct EpiInProj {
    unsigned char* ws; unsigned char* G; const float* rope; const float* bgate; unsigned* nrm;
    __device__ __forceinline__ void operator()(const f32x4 (&acc)[2][2][4][2], const Unit& u, int wr, int wc, int fr, int fq) const {
        const int pn = u.pn;
        const int row0 = u.pm * 256 + wr * 64 + fr;
#pragma unroll
        for (int bj = 0; bj < 2; ++bj) {
            const int c8 = pn * 256 + bj * 128 + wc * 32 + fq * 8;
            if (pn < 6) {
                bf16_t* base = (bf16_t*)(ws + WS_QF + (size_t)(pn >> 1) * (WS_KF - WS_QF)); const int col = c8 & 511; const float sc = pn < 2 ? C2 : 1.0f;
                float mx = 0.f;
#pragma unroll
                for (int ai = 0; ai < 2; ++ai)
#pragma unroll
                    for (int m = 0; m < 4; ++m) { const int row = row0 + ai * 128 + m * 16;
                        const f32x4 v0 = acc[ai][bj][m][0] * sc, v1 = acc[ai][bj][m][1] * sc;
                        *(u32x4*)(base + (size_t)row * 512 + col) = pack8(v0, v1);
                        if (pn < 4) { float ss = (v0[0] * v0[0] + v0[1] * v0[1]) + (v0[2] * v0[2] + v0[3] * v0[3]) + (v1[0] * v1[0] + v1[1] * v1[1]) + (v1[2] * v1[2] + v1[3] * v1[3]);
                            ss += __shfl_xor(ss, 16); ss += __shfl_xor(ss, 32); mx = fmaxf(mx, ss); } }
                if (pn < 4) {
#pragma unroll
                    for (int o = 1; o < 16; o <<= 1) mx = fmaxf(mx, __shfl_xor(mx, o));
                    const int hd = (pn & 1) * 4 + bj * 2 + (wc >> 1), bb = u.pm >> 5;
                    if (fr == 0 && fq == 0) atomicMax(nrm + (pn >> 1) * 128 + (bb * 8 + hd) * 2 + (wc & 1), __float_as_uint(mx)); }
            } else if (pn < 8 || (pn == 8 && bj == 0)) {
                const bool isq = pn < 8; const int cc = c8 - (isq ? 1536 : 2048); const int hd = cc >> 6, d0 = (cc & 63) >> 1;
                bf16_t* base = (bf16_t*)(ws + (isq ? WS_QS : WS_KS)); const int ld = isq ? 512 : 128; const float sc = isq ? C2 : 1.0f;
#pragma unroll
                for (int ai = 0; ai < 2; ++ai) {
                    f32x4 csv[4], snv[4];
#pragma unroll
                    for (int m = 0; m < 4; ++m) { const int row = row0 + ai * 128 + m * 16; csv[m] = *(const f32x4*)(rope + (size_t)row * 64 + d0); snv[m] = *(const f32x4*)(rope + (size_t)row * 64 + 32 + d0); }
                    asm volatile("" ::: "memory");
#pragma unroll
                    for (int m = 0; m < 4; ++m) { const int row = row0 + ai * 128 + m * 16;
                        const f32x4 x1 = acc[ai][bj][m][0], x2 = acc[ai][bj][m][1];
                        const f32x4 lo = (x1 * csv[m] - x2 * snv[m]) * sc, hi = (x2 * csv[m] + x1 * snv[m]) * sc;
                        bf16_t* p = base + (size_t)row * ld + hd * 64 + d0;
                        *(u32x2*)p = pack4(lo); *(u32x2*)(p + 32) = pack4(hi); }
                    asm volatile("" ::: "memory"); }
            } else if (pn == 8) {
                const int col = c8 - 2176;
#pragma unroll
                for (int ai = 0; ai < 2; ++ai)
#pragma unroll
                    for (int m = 0; m < 4; ++m) { const int row = row0 + ai * 128 + m * 16;
                        *(u32x4*)((bf16_t*)(ws + WS_VS) + (size_t)row * 128 + col) = pack8(acc[ai][bj][m][0], acc[ai][bj][m][1]); }
            } else {
                const int j = c8 - 2304;
                const f32x4 b0 = *(const f32x4*)(bgate + j), b1 = *(const f32x4*)(bgate + j + 4);
#pragma unroll
                for (int ai = 0; ai < 2; ++ai)
#pragma unroll
                    for (int m = 0; m < 4; ++m) { const int row = row0 + ai * 128 + m * 16;
                        f32x4 v0 = acc[ai][bj][m][0] + b0, v1 = acc[ai][bj][m][1] + b1;
                        unsigned lo8 = 0u, hi8 = 0u; const unsigned qmin = (j >= 1024) ? 1u : 0u;
#pragma unroll
                        for (int q = 0; q < 4; ++q) { unsigned a_ = (unsigned)(fast_sigmoid(v0[q]) * 255.0f + 0.5f), b_ = (unsigned)(fast_sigmoid(v1[q]) * 255.0f + 0.5f); a_ = a_ < qmin ? qmin : a_; b_ = b_ < qmin ? qmin : b_; lo8 |= a_ << (8 * q); hi8 |= b_ << (8 * q); }
                        u32x2 w; w.x = lo8; w.y = hi8; *(u32x2*)(G + (size_t)row * 2048 + j) = w; }
            }
        }
    }
};
struct EpiProjF {
    static constexpr bool HAS_MID = true;
    bf16_t* __restrict__ M; const unsigned char* __restrict__ G;
    __device__ __forceinline__ void mid(f32x4 (&acc)[2][2][4][2], const Unit& u, int wr, int wc, int fr, int fq) const {
        unsigned base = (unsigned)(u.pm * 256 + wr * 64 + fr) * 2048u + (unsigned)(u.pn * 256 + wc * 32 + fq * 8);
        asm volatile("" : "+v"(base));
#pragma unroll
        for (int ai = 0; ai < 2; ++ai)
#pragma unroll
            for (int mh = 0; mh < 2; ++mh) {
                u32x2 gf[2][2], gs[2][2];
#pragma unroll
                for (int m2 = 0; m2 < 2; ++m2)
#pragma unroll
                    for (int bj = 0; bj < 2; ++bj) { const unsigned off = base + (unsigned)((ai * 128 + (mh * 2 + m2) * 16) * 2048 + bj * 128); gf[m2][bj] = *(const u32x2*)(G + off); gs[m2][bj] = *(const u32x2*)(G + off + 1024u); }
                asm volatile("" ::: "memory");
#pragma unroll
                for (int m2 = 0; m2 < 2; ++m2)
#pragma unroll
                    for (int bj = 0; bj < 2; ++bj) { const u32x2 a = gf[m2][bj], b = gs[m2][bj]; const int m = mh * 2 + m2;
#define RAT(x, y, sh) ((float)(((x) >> (sh)) & 0xffu) * __builtin_amdgcn_rcpf((float)(((y) >> (sh)) & 0xffu)))
                        acc[ai][bj][m][0][0] *= RAT(a.x, b.x, 0); acc[ai][bj][m][0][1] *= RAT(a.x, b.x, 8); acc[ai][bj][m][0][2] *= RAT(a.x, b.x, 16); acc[ai][bj][m][0][3] *= RAT(a.x, b.x, 24);
                        acc[ai][bj][m][1][0] *= RAT(a.y, b.y, 0); acc[ai][bj][m][1][1] *= RAT(a.y, b.y, 8); acc[ai][bj][m][1][2] *= RAT(a.y, b.y, 16); acc[ai][bj][m][1][3] *= RAT(a.y, b.y, 24);
#undef RAT
                    }
                asm volatile("" ::: "memory");
            }
    }
    __device__ __forceinline__ void operator()(const f32x4 (&acc)[2][2][4][2], const Unit& u, int wr, int wc, int fr, int fq) const {
        unsigned rowc = (unsigned)(u.pm * 256 + wr * 64 + fr) * 1024u + (unsigned)(u.pn * 256 + wc * 32 + fq * 8);
        asm volatile("" : "+v"(rowc));
        const unsigned colp = (unsigned)(u.pn * 256 + wc * 32 + fq * 8);
        constexpr float I255 = 1.0f / 255.0f;
#pragma unroll
        for (int ai = 0; ai < 2; ++ai) {
            u32x2 gw[4][2];
#pragma unroll
            for (int m = 0; m < 4; ++m)
#pragma unroll
                for (int bj = 0; bj < 2; ++bj) { const unsigned mo = rowc + (unsigned)((ai * 128 + m * 16) * 1024 + bj * 128); gw[m][bj] = *(const u32x2*)(G + (2u * mo - colp - (unsigned)(bj * 128)) + 1024u); }
            asm volatile("" ::: "memory");
#pragma unroll
            for (int m = 0; m < 4; ++m)
#pragma unroll
                for (int bj = 0; bj < 2; ++bj) { const unsigned mo = rowc + (unsigned)((ai * 128 + m * 16) * 1024 + bj * 128);
                    const u32x2 g = gw[m][bj]; f32x4 v0 = acc[ai][bj][m][0], v1 = acc[ai][bj][m][1];
                    v0[0] *= (float)(g.x & 0xffu) * I255; v0[1] *= (float)((g.x >> 8) & 0xffu) * I255; v0[2] *= (float)((g.x >> 16) & 0xffu) * I255; v0[3] *= (float)(g.x >> 24) * I255;
                    v1[0] *= (float)(g.y & 0xffu) * I255; v1[1] *= (float)((g.y >> 8) & 0xffu) * I255; v1[2] *= (float)((g.y >> 16) & 0xffu) * I255; v1[3] *= (float)(g.y >> 24) * I255;
                    *(u32x4*)(M + mo) = pack8(v0, v1); }
            asm volatile("" ::: "memory");
        }
    }
};
struct EpiOut {
    const float* __restrict__ X; bf16_t* __restrict__ O;
    __device__ __forceinline__ void operator()(const f32x4 (&acc)[2][2][4][2], const Unit& u, int wr, int wc, int fr, int fq) const {
        const int row0 = u.pm * 256 + wr * 64 + fr; const int col0 = u.pn * 256 + wc * 32 + fq * 8;
#pragma unroll
        for (int ai = 0; ai < 2; ++ai) {
            f32x4 xa[4][2][2];
#pragma unroll
            for (int m = 0; m < 4; ++m)
#pragma unroll
                for (int bj = 0; bj < 2; ++bj) { const size_t off = (size_t)(row0 + ai * 128 + m * 16) * 1024 + col0 + bj * 128;
                    xa[m][bj][0] = *(const f32x4*)(X + off); xa[m][bj][1] = *(const f32x4*)(X + off + 4); }
            asm volatile("" ::: "memory");
#pragma unroll
            for (int m = 0; m < 4; ++m)
#pragma unroll
                for (int bj = 0; bj < 2; ++bj) { const size_t off = (size_t)(row0 + ai * 128 + m * 16) * 1024 + col0 + bj * 128;
                    *(u32x4*)(O + off) = pack8(xa[m][bj][0] + acc[ai][bj][m][0], xa[m][bj][1] + acc[ai][bj][m][1]); }
            asm volatile("" ::: "memory");
        }
    }
};
struct EpiMoe1 {
    bf16_t* __restrict__ H; const float* __restrict__ saL; const float* __restrict__ wsc;
    __device__ __forceinline__ void operator()(const i32x4 (&acc)[2][2][4][2], const Unit& u, int wr, int wc, int fr, int fq) const {
        const int row0 = u.rbg * 256 + wr * 64 + fr;
        float sr[2][4];
#pragma unroll
        for (int ai = 0; ai < 2; ++ai)
#pragma unroll
            for (int m = 0; m < 4; ++m) { const int r = ai * 128 + wr * 64 + m * 16 + fr; sr[ai][m] = saL[u.rowbase + (r < u.rows ? r : 0)]; }
        f32x4 s1[2], s3[2];
#pragma unroll
        for (int bj = 0; bj < 2; ++bj) { const float* p = wsc + (size_t)u.e * 1024 + u.pn * 256 + bj * 128 + wc * 32 + fq * 8; s1[bj] = *(const f32x4*)p; s3[bj] = *(const f32x4*)(p + 4); }
        asm volatile("" ::: "memory");
#pragma unroll
        for (int bj = 0; bj < 2; ++bj) {
            const int hcol = u.pn * 128 + bj * 64 + wc * 16 + fq * 4;
#pragma unroll
            for (int ai = 0; ai < 2; ++ai)
#pragma unroll
                for (int m = 0; m < 4; ++m) { const int row = row0 + ai * 128 + m * 16; const float r = sr[ai][m];
                    const i32x4 a = acc[ai][bj][m][0], b = acc[ai][bj][m][1]; f32x4 h;
#pragma unroll
                    for (int q = 0; q < 4; ++q) { const float av = (float)a[q] * (r * s1[bj][q]), bv = (float)b[q] * (r * s3[bj][q]); h[q] = av * fast_sigmoid(av) * bv; }
                    *(u32x2*)(H + (size_t)row * 512 + hcol) = pack4(h); }
        }
    }
};
struct EpiMoe2 {
    bf16_t* __restrict__ Y; const int* __restrict__ list; const float* __restrict__ gate;
    __device__ __forceinline__ void operator()(const f32x4 (&acc)[2][2][4][2], const Unit& u, int wr, int wc, int fr, int fq) const {
        int slot[2][4]; float g[2][4];
#pragma unroll
        for (int ai = 0; ai < 2; ++ai)
#pragma unroll
            for (int m = 0; m < 4; ++m) { const int r = ai * 128 + wr * 64 + m * 16 + fr; const int rr = r < u.rows ? r : 0;
                slot[ai][m] = list[u.rowbase + rr]; g[ai][m] = gate[u.rowbase + rr]; }
        asm volatile("" ::: "memory");
#pragma unroll
        for (int ai = 0; ai < 2; ++ai)
#pragma unroll
            for (int m = 0; m < 4; ++m) { const int r = ai * 128 + wr * 64 + m * 16 + fr;
                if (r < u.rows) {
#pragma unroll
                    for (int bj = 0; bj < 2; ++bj) { const int col = u.pn * 256 + bj * 128 + wc * 32 + fq * 8;
                        *(u32x4*)(Y + (size_t)slot[ai][m] * 1024 + col) = pack8(acc[ai][bj][m][0] * g[ai][m], acc[ai][bj][m][1] * g[ai][m]); } } }
    }
};

struct Args { const void* in[19]; float* out; unsigned char* ws; int ph_lo, ph_hi, coop, pad; };
struct Frame {
    LAS unsigned char* lds; int tid, lane, wave, vcu, G; unsigned char* ws;
};

template <bool NT, class DstFn>
__device__ __forceinline__ void tr_item(const float* src, int ldw, bf16_t* WT, int ldt, int k0, DstFn dst, LAS float* scr, int lane) {
    const int kr = lane >> 3, c4 = lane & 7;
    f32x4 v[8];
#pragma unroll
    for (int i = 0; i < 8; ++i) { const f32x4* p = (const f32x4*)(src + (size_t)(kr + 8 * i) * ldw + 4 * c4); v[i] = NT ? __builtin_nontemporal_load(p) : *p; }
#pragma unroll
    for (int i = 0; i < 8; ++i) { LAS float* p = scr + (kr + 8 * i) * 33 + 4 * c4; p[0] = v[i].x; p[1] = v[i].y; p[2] = v[i].z; p[3] = v[i].w; }
    LDS_WAIT(); asm volatile("" ::: "memory");
    const int c = lane & 7;
#pragma unroll
    for (int j = 0; j < 4; ++j) { const int n = (lane >> 3) + 8 * j; const LAS float* sp = scr + (8 * c) * 33 + n;
        u32x4 o; o.x = pk2(sp[0 * 33], sp[1 * 33]); o.y = pk2(sp[2 * 33], sp[3 * 33]); o.z = pk2(sp[4 * 33], sp[5 * 33]); o.w = pk2(sp[6 * 33], sp[7 * 33]);
        u32x4* q = (u32x4*)(WT + (size_t)dst(n) * ldt + k0 + 8 * c); if (NT) __builtin_nontemporal_store(o, q); else *q = o; }
    LDS_WAIT(); asm volatile("" ::: "memory");
}
__device__ __forceinline__ int win_dst_row(int sc) {
    if (sc < 1536) return sc;
    if (sc < 1544 + 640) { const int cc = sc - 1544, hd = cc >> 6, d = cc & 63; return 1536 + hd * 64 + 8 * ((d & 31) >> 2) + 4 * (d >> 5) + (d & 3); }
    return sc - 8;
}
__device__ __forceinline__ void sincos_d(double a, double& s, double& c) {
    const double k = __builtin_rint(a * 0.63661977236758134308);
    double r = __builtin_fma(-k, 1.57079632679489655800e+00, a); r = __builtin_fma(-k, 6.12323399573676603587e-17, r);
    const double r2 = r * r;
    double ps = 1.58969099521155010221e-10; ps = __builtin_fma(ps, r2, -2.50507602534068634195e-08); ps = __builtin_fma(ps, r2, 2.75573137070700676789e-06);
    ps = __builtin_fma(ps, r2, -1.98412698298579493134e-04); ps = __builtin_fma(ps, r2, 8.33333333332248946124e-03); ps = __builtin_fma(ps, r2, -1.66666666666666324348e-01);
    const double sr = __builtin_fma(ps * r2, r, r);
    double pc = -1.13596475577881948265e-11; pc = __builtin_fma(pc, r2, 2.08757232129817482790e-09); pc = __builtin_fma(pc, r2, -2.75573143513906633035e-07);
    pc = __builtin_fma(pc, r2, 2.48015872894767294178e-05); pc = __builtin_fma(pc, r2, -1.38888888888741095749e-03); pc = __builtin_fma(pc, r2, 4.16666666666666019037e-02);
    const double cr = __builtin_fma(pc * r2, r2, __builtin_fma(-0.5, r2, 1.0));
    const int q = (int)((long long)k & 3);
    s = (q == 0) ? sr : (q == 1) ? cr : (q == 2) ? -sr : -cr;
    c = (q == 0) ? cr : (q == 1) ? -sr : (q == 2) ? -cr : sr;
}
constexpr int W2_CHUNKS = 342, W13_CHUNKS = 256;
__device__ __forceinline__ void w2_convert_chunk(const Frame& F, const Args& a, int chunk) {
    const float* w2 = (const float*)a.in[17]; bf16_t* W2T = (bf16_t*)(F.ws + WS_W2T);
    int tid = threadIdx.x; asm volatile("" : "+v"(tid));
    const int lane = tid & 63, wave = __builtin_amdgcn_readfirstlane(tid >> 6);
    LAS float* scr = (LAS float*)(F.lds + wave * 8448);
#pragma unroll 1
    for (int k = 0; k < 6; ++k) {
        const int r = chunk * 48 + wave * 6 + k;
        if (r < NE * 8 * 32) { const int e = r >> 8, rr = r & 255, kb = rr / 32, nb = rr % 32;
            tr_item<true>(w2 + (size_t)e * 512 * 1024 + (size_t)(64 * kb) * 1024 + 32 * nb, 1024, W2T + (size_t)e * 1024 * 512, 512, 64 * kb, [=](int n) { return 32 * nb + n; }, scr, lane); }
    }
}
__device__ __forceinline__ void w13q_convert_chunk(const Frame& F, const Args& a, int chunk) {
    const float* w1 = (const float*)a.in[15]; const float* w3 = (const float*)a.in[16];
    signed char* W13Q = (signed char*)(F.ws + WS_W13T); float* wsc = (float*)(F.ws + WS_WSC);
    int tid = threadIdx.x; asm volatile("" : "+v"(tid));
    const int lane = tid & 63, wave = __builtin_amdgcn_readfirstlane(tid >> 6);
    LAS float* scr = (LAS float*)(F.lds + wave * 8448); LAS float* cmx = (LAS float*)(F.lds + 8 * 8448) + wave * 32;
    const int task = chunk * 8 + wave, e = task >> 5, which = (task >> 4) & 1, nb = task & 15;
    const float* src = (which ? w3 : w1) + (size_t)e * 1024 * 512 + 32 * nb;
    const int kr = lane >> 3, c4 = lane & 7;
    f32x4 mx = {0.f, 0.f, 0.f, 0.f};
#define W13_LD8(dst, kb_) do { _Pragma("unroll") for (int i = 0; i < 8; ++i) dst[i] = __builtin_nontemporal_load((const f32x4*)(src + (size_t)(64 * (kb_) + kr + 8 * i) * 512 + 4 * c4)); } while (0)
#define W13_MX8(srcv) do { _Pragma("unroll") for (int i = 0; i < 8; ++i) { mx.x = fmaxf(mx.x, fabsf(srcv[i].x)); mx.y = fmaxf(mx.y, fabsf(srcv[i].y)); mx.z = fmaxf(mx.z, fabsf(srcv[i].z)); mx.w = fmaxf(mx.w, fabsf(srcv[i].w)); } } while (0)
    { f32x4 va[8], vb[8], vc[8];
      W13_LD8(va, 0); W13_LD8(vb, 1);
#pragma unroll 1
      for (int kb = 0; kb < 15; kb += 3) { W13_LD8(vc, kb + 2); W13_MX8(va); W13_LD8(va, kb + 3); W13_MX8(vb); if (kb + 4 < 16) W13_LD8(vb, kb + 4); W13_MX8(vc); }
      W13_MX8(va); }
#undef W13_LD8
#undef W13_MX8
#pragma unroll
    for (int o = 8; o < 64; o <<= 1) { mx.x = fmaxf(mx.x, __shfl_xor(mx.x, o)); mx.y = fmaxf(mx.y, __shfl_xor(mx.y, o)); mx.z = fmaxf(mx.z, __shfl_xor(mx.z, o)); mx.w = fmaxf(mx.w, __shfl_xor(mx.w, o)); }
    if (kr == 0) { cmx[4 * c4 + 0] = mx.x; cmx[4 * c4 + 1] = mx.y; cmx[4 * c4 + 2] = mx.z; cmx[4 * c4 + 3] = mx.w; }
    LDS_WAIT(); asm volatile("" ::: "memory");
    if (lane < 32) { const int u = 32 * nb + lane; wsc[(size_t)e * 1024 + 8 * (u >> 2) + 4 * which + (u & 3)] = cmx[lane] * (1.0f / 127.0f); }
    const int c = lane & 7;
    f32x4 v[8], vn[8], vnn[8];
#pragma unroll
    for (int i = 0; i < 8; ++i) { v[i] = *(const f32x4*)(src + (size_t)(kr + 8 * i) * 512 + 4 * c4); vn[i] = *(const f32x4*)(src + (size_t)(64 + kr + 8 * i) * 512 + 4 * c4); }
#pragma unroll 1
    for (int kb = 0; kb < 16; ++kb) {
        const int kbn = kb + 2 < 16 ? kb + 2 : 15;
#pragma unroll
        for (int i = 0; i < 8; ++i) vnn[i] = *(const f32x4*)(src + (size_t)(64 * kbn + kr + 8 * i) * 512 + 4 * c4);
#pragma unroll
        for (int i = 0; i < 8; ++i) { LAS float* p = scr + (kr + 8 * i) * 33 + 4 * c4; p[0] = v[i].x; p[1] = v[i].y; p[2] = v[i].z; p[3] = v[i].w; }
        LDS_WAIT(); asm volatile("" ::: "memory");
#pragma unroll
        for (int j = 0; j < 4; ++j) { const int n = (lane >> 3) + 8 * j; const LAS float* sp = scr + (8 * c) * 33 + n;
            const float cm = cmx[n]; const float inv = cm > 0.f ? 127.0f / cm : 0.f;
            unsigned lo = 0u, hi = 0u;
#pragma unroll
            for (int i = 0; i < 4; ++i) { lo |= ((unsigned)(int)__builtin_rintf(sp[i * 33] * inv) & 0xffu) << (8 * i); hi |= ((unsigned)(int)__builtin_rintf(sp[(4 + i) * 33] * inv) & 0xffu) << (8 * i); }
            const int u = 32 * nb + n; u32x2 o; o.x = lo; o.y = hi;
            __builtin_nontemporal_store(o, (u32x2*)(W13Q + ((size_t)e * 1024 + 8 * (u >> 2) + 4 * which + (u & 3)) * 1024 + 64 * kb + 8 * c)); }
        LDS_WAIT(); asm volatile("" ::: "memory");
#pragma unroll
        for (int i = 0; i < 8; ++i) { v[i] = vn[i]; vn[i] = vnn[i]; } }
}
__device__ __forceinline__ void p0_prologue(const Frame& F, const Args& a) {
    const float* x = (const float*)a.in[0]; const int* positions = (const int*)a.in[1]; const float* attn_norm = (const float*)a.in[2]; const float* w_in = (const float*)a.in[3];
    const float* b_forget = (const float*)a.in[4]; const float* w_pf = (const float*)a.in[7]; const float* w_ps = (const float*)a.in[8]; const float* w_out = (const float*)a.in[9];
    const float* w_group = (const float*)a.in[11]; const float* w_expert = (const float*)a.in[13]; const float* w1 = (const float*)a.in[15]; const float* w3 = (const float*)a.in[16]; const float* w2 = (const float*)a.in[17];
    unsigned char* ws = F.ws;
    bf16_t* WinT = (bf16_t*)(ws + WS_WIN_T); bf16_t* WpfT = (bf16_t*)(ws + WS_WPF_T); bf16_t* WpsT = (bf16_t*)(ws + WS_WPS_T); bf16_t* WoutT = (bf16_t*)(ws + WS_WOUT_T);
    bf16_t* W13T = (bf16_t*)(ws + WS_W13T); bf16_t* W2T = (bf16_t*)(ws + WS_W2T); bf16_t* Hn = (bf16_t*)(ws + WS_R1);
    float* rope = (float*)(ws + WS_ROPE); float* logf_ = (float*)(ws + WS_LOGF); bf16_t* WrH = (bf16_t*)(ws + WS_WR); bf16_t* WrL = WrH + 80 * 1024;
    LAS float* scr = (LAS float*)(F.lds + F.wave * 8448);
    LAS f32x4* wfl = (LAS f32x4*)(F.lds + 8 * 8448);
    for (int idx = F.tid; idx < 2048; idx += NTHREADS) { const int q = idx >> 7, half = (idx >> 6) & 1, ln = idx & 63, j = q >> 2, i = q & 3, k = 4 * ln + i + 256 * j;
        wfl[idx] = *(const f32x4*)(w_in + (size_t)k * N_IN + 1536 + 4 * half); }
    const int gw = F.vcu * NWAVES + F.wave, NGW = F.G * NWAVES;
    constexpr int I_IN = 16 * 136, I_PF = 8 * 32, I_PS = 8 * 32, I_OUT = 16 * 32;
    constexpr int NITEMS = I_IN + I_PF + I_PS + I_OUT;
    for (int it = gw; it < NITEMS; it += NGW) {
        int r = it;
        if (r < I_IN) { const int kb = r / 136, nb = r % 136; const int n0 = nb < 48 ? 32 * nb : 1544 + 32 * (nb - 48);
            tr_item<false>(w_in + (size_t)(64 * kb) * N_IN + n0, N_IN, WinT, 1024, 64 * kb, [=](int n) { return win_dst_row(n0 + n); }, scr, F.lane); continue; } r -= I_IN;
        if (r < I_PF) { const int kb = r / 32, nb = r % 32; tr_item<false>(w_pf + (size_t)(64 * kb) * 1024 + 32 * nb, 1024, WpfT, 1024, 64 * kb, [=](int n) { return 32 * nb + n; }, scr, F.lane); continue; } r -= I_PF;
        if (r < I_PS) { const int kb = r / 32, nb = r % 32; tr_item<false>(w_ps + (size_t)(64 * kb) * 1024 + 32 * nb, 1024, WpfT, 1024, 512 + 64 * kb, [=](int n) { return 32 * nb + n; }, scr, F.lane); continue; } r -= I_PS;
        { const int kb = r / 32, nb = r % 32; tr_item<false>(w_out + (size_t)(64 * kb) * 1024 + 32 * nb, 1024, WoutT, 1024, 64 * kb, [=](int n) { return 32 * nb + n; }, scr, F.lane); }
    }
    __syncthreads();
    f32x4 gv[4];
#pragma unroll
    for (int j = 0; j < 4; ++j) gv[j] = *((const f32x4*)attn_norm + F.lane + 64 * j);
    for (int m = gw; m < T; m += NGW) {
        const f32x4* xr = (const f32x4*)(x + (size_t)m * DM) + F.lane;
        f32x4 v[4]; float ss = 0.f;
#pragma unroll
        for (int j = 0; j < 4; ++j) { v[j] = xr[64 * j]; ss += (v[j].x * v[j].x + v[j].y * v[j].y) + (v[j].z * v[j].z + v[j].w * v[j].w); }
        const float rstd = 1.0f / sqrtf(wave_sum(ss) * (1.0f / DM) + EPS);
        unsigned long long* o8 = (unsigned long long*)(Hn + (size_t)m * DM) + F.lane;
        float fa[8];
#pragma unroll
        for (int q = 0; q < 8; ++q) fa[q] = 0.f;
#pragma unroll
        for (int j = 0; j < 4; ++j) { v[j] = v[j] * rstd * gv[j];
            o8[64 * j] = (unsigned long long)pk2(v[j].x, v[j].y) | ((unsigned long long)pk2(v[j].z, v[j].w) << 32);
#pragma unroll
            for (int i = 0; i < 4; ++i) { const f32x4 wa = wfl[((j * 4 + i) * 2 + 0) * 64 + F.lane], wb = wfl[((j * 4 + i) * 2 + 1) * 64 + F.lane]; const float hv = v[j][i];
                fa[0] += hv * wa.x; fa[1] += hv * wa.y; fa[2] += hv * wa.z; fa[3] += hv * wa.w; fa[4] += hv * wb.x; fa[5] += hv * wb.y; fa[6] += hv * wb.z; fa[7] += hv * wb.w; } }
#pragma unroll
        for (int q = 0; q < 8; ++q) fa[q] = wave_sum(fa[q]);
        float z = fa[0];
#pragma unroll
        for (int q = 1; q < 8; ++q) z = (F.lane == q) ? fa[q] : z;
        if (F.lane < 8) { const float y = z + b_forget[F.lane]; const float ls = fminf(y, 0.f) - log1pf(__expf(-fabsf(y))); logf_[(size_t)m * 8 + F.lane] = ls; }
    }
    const int gt = F.vcu * NTHREADS + F.tid, NGT = F.G * NTHREADS;
    { const int i = gt & 31;
      const double invf = exp2(-(double)i * (13.287712379549449 / 32.0));
      for (int idx = gt; idx < T * 32; idx += 4 * NGT) {
          int pos[4];
#pragma unroll
          for (int k = 0; k < 4; ++k) { const int t = (idx + k * NGT) >> 5; pos[k] = t < T ? positions[t] : 0; }
#pragma unroll
          for (int k = 0; k < 4; ++k) { const int t = (idx + k * NGT) >> 5; if (t < T) { double s, c; sincos_d((double)pos[k] * invf, s, c);
              rope[(size_t)t * 64 + i] = (float)c; rope[(size_t)t * 64 + 32 + i] = (float)s; } } } }
    for (int idx = gt; idx < 80 * 1024; idx += NGT) { const int j = idx >> 10, k = idx & 1023;
        const float w = j < 8 ? w_group[k * 8 + j] : (j < 72 ? w_expert[k * 64 + (j - 8)] : 0.f);
        const unsigned h = f2bf(w); WrH[idx] = (bf16_t)h; WrL[idx] = (bf16_t)f2bf(w - bf2f(h)); }
}

__device__ __forceinline__ void cumsum_block(const Frame& F, int seq) {
    const float* logf_ = (const float*)(F.ws + WS_LOGF); float* cum = (float*)(F.ws + WS_CUM);
    const int b = seq >> 3, h = seq & 7; const int s0 = F.tid * 16;
    double loc[16]; double run = 0.0;
#pragma unroll
    for (int i = 0; i < 16; ++i) { run += (double)logf_[((size_t)b * SEQ + s0 + i) * 8 + h]; loc[i] = run; }
    double inc = run;
#pragma unroll
    for (int o = 1; o < 64; o <<= 1) { const double t = __shfl_up(inc, o); if (F.lane >= o) inc += t; }
    LAS double* wt = (LAS double*)(F.lds + MISC_OFF + 1024);
    if (F.lane == 63) wt[F.wave] = inc;
    __syncthreads();
    double off = inc - run;
#pragma unroll
    for (int w = 0; w < 8; ++w) if (w < F.wave) off += wt[w];
#pragma unroll
    for (int i = 0; i < 16; ++i) cum[((size_t)b * 8 + h) * SEQ + s0 + i] = (float)((off + loc[i]) * 1.4426950408889634);
    __syncthreads();
}

__device__ __forceinline__ int crow(int r, int hi) { return (r & 3) + 8 * (r >> 2) + 4 * hi; }
__device__ __forceinline__ void attn_pv(f32x16* o, int vb, bf16x8 pa0, bf16x8 pa1, bf16x8 pa2, bf16x8 pa3) {
#pragma unroll
    for (int d0 = 0; d0 < 2; ++d0) { s16x4 lo[4], hi[4];
#pragma unroll
        for (int ks = 0; ks < 4; ++ks) {
            asm volatile("ds_read_b64_tr_b16 %0,%1 offset:%c2" : "=&v"(lo[ks]) : "v"(vb), "i"(d0 * 4096 + ks * 1024) : "memory");
            asm volatile("ds_read_b64_tr_b16 %0,%1 offset:%c2" : "=&v"(hi[ks]) : "v"(vb), "i"(d0 * 4096 + ks * 1024 + 512) : "memory"); }
        asm volatile("s_waitcnt lgkmcnt(0)" ::: "memory"); __builtin_amdgcn_sched_barrier(0);
#define PK(k) (bf16x8){lo[k][0], lo[k][1], lo[k][2], lo[k][3], hi[k][0], hi[k][1], hi[k][2], hi[k][3]}
        o[d0] = __builtin_amdgcn_mfma_f32_32x32x16_bf16(pa0, PK(0), o[d0], 0, 0, 0);
        o[d0] = __builtin_amdgcn_mfma_f32_32x32x16_bf16(pa1, PK(1), o[d0], 0, 0, 0);
        o[d0] = __builtin_amdgcn_mfma_f32_32x32x16_bf16(pa2, PK(2), o[d0], 0, 0, 0);
        o[d0] = __builtin_amdgcn_mfma_f32_32x32x16_bf16(pa3, PK(3), o[d0], 0, 0, 0);
#undef PK
    }
}
template <bool FOX>
__device__ __forceinline__ void attn_unit(LAS unsigned char* lds, const bf16_t* Qp, int ldq, const bf16_t* Kp, const bf16_t* Vp, int ldkv, bf16_t* Op, int ldo, const float* cum, float sink2, int q0) {
    int tid = threadIdx.x; asm volatile("" : "+v"(tid));
    const int lane = tid & 63, r32 = lane & 31, hi = lane >> 5; const int wid = __builtin_amdgcn_readfirstlane(tid >> 6);
    LAS unsigned char* Kl = lds; LAS unsigned char* Vl = lds + 8192; LAS float* csl = (LAS float*)(lds + 16384); LAS float* wsf = (LAS float*)(lds + 16384 + 256) + wid * 64;
    const int qw0 = q0 + wid * 32, qpos = qw0 + r32;
    bf16x8 qr[4];
#pragma unroll
    for (int d0 = 0; d0 < 4; ++d0) qr[d0] = *(const bf16x8*)(Qp + (size_t)qpos * ldq + d0 * 16 + hi * 8);
    const float ctq = FOX ? cum[qpos] : 0.f;
    float mrow = FOX ? -1e30f : sink2; float lrow = FOX ? 0.f : (hi == 0 ? 1.f : 0.f);
    f32x16 o[2];
#pragma unroll
    for (int r = 0; r < 16; ++r) { o[0][r] = 0.f; o[1][r] = 0.f; }
    const int t_lo = FOX ? 0 : (q0 / 64 - 2 < 0 ? 0 : q0 / 64 - 2), t_hi = q0 / 64 + 4;
    const int vb = (int)(unsigned)(uintptr_t)Vl + ((lane >> 4) & 1) * 32 + (lane & 3) * 8 + (4 * hi + ((lane & 15) >> 2)) * 64;
    for (int t = t_lo; t < t_hi; ++t) {
        __syncthreads();
        { const u32x4 kv = *(const u32x4*)(Kp + (size_t)(64 * t + lane) * ldkv + wid * 8);
          const u32x4 vv = *(const u32x4*)(Vp + (size_t)(64 * t + 16 * (wid & 3) + (lane >> 2)) * ldkv + (wid >> 2) * 32 + (lane & 3) * 8);
          *(LAS u32x4*)(Kl + wid * 1024 + lane * 16) = kv; *(LAS u32x4*)(Vl + wid * 1024 + lane * 16) = vv;
          if (FOX && tid < 64) csl[tid] = cum[64 * t + tid]; }
        __syncthreads();
        const bool rel = (64 * t <= qw0 + 31) && (FOX || (64 * t + 63 >= qw0 - (WINDOW - 1)));
        if (rel) {
            f32x16 p0, p1;
#pragma unroll
            for (int r = 0; r < 16; ++r) { p0[r] = 0.f; p1[r] = 0.f; }
            { const LAS unsigned char* kb = Kl + hi * 1024 + r32 * 16;
#pragma unroll
              for (int d0 = 0; d0 < 4; ++d0) { const bf16x8 b0 = *(const LAS bf16x8*)(kb + d0 * 2048), b1 = *(const LAS bf16x8*)(kb + d0 * 2048 + 512);
                  p0 = __builtin_amdgcn_mfma_f32_32x32x16_bf16(b0, qr[d0], p0, 0, 0, 0); p1 = __builtin_amdgcn_mfma_f32_32x32x16_bf16(b1, qr[d0], p1, 0, 0, 0); } }
            float rm = -1e30f;
#pragma unroll
            for (int r = 0; r < 16; ++r) { const int kr = crow(r, hi); const int kv0 = 64 * t + kr, kv1 = kv0 + 32;
                float s0 = p0[r], s1 = p1[r];
                if (FOX) { s0 += ctq - csl[kr]; s1 += ctq - csl[kr + 32]; }
                const bool v0 = (kv0 <= qpos) && (FOX || (qpos - kv0 < WINDOW)), v1 = (kv1 <= qpos) && (FOX || (qpos - kv1 < WINDOW));
                s0 = v0 ? s0 : -1e30f; s1 = v1 ? s1 : -1e30f; p0[r] = s0; p1[r] = s1; rm = fmaxf(rm, fmaxf(s0, s1)); }
            rm = fmaxf(rm, __shfl_xor(rm, 32));
            const float mnew = fmaxf(mrow, rm); const float f = __builtin_amdgcn_exp2f(mrow - mnew); mrow = mnew;
            float ls = 0.f;
#pragma unroll
            for (int r = 0; r < 16; ++r) { p0[r] = __builtin_amdgcn_exp2f(p0[r] - mnew); p1[r] = __builtin_amdgcn_exp2f(p1[r] - mnew); ls += p0[r] + p1[r]; }
            lrow = lrow * f + ls;
            if (__any(f != 1.0f)) {
                if (hi == 0) wsf[r32] = f;
                LDS_WAIT();
#pragma unroll
                for (int r = 0; r < 16; ++r) { const float fr_ = wsf[crow(r, hi)]; o[0][r] *= fr_; o[1][r] *= fr_; }
            }
            u32x4 w0, w1, w2, w3;
            w0.x = cvt_pk_bf16(p0[0], p0[1]); w0.y = cvt_pk_bf16(p0[2], p0[3]); w0.z = cvt_pk_bf16(p0[4], p0[5]); w0.w = cvt_pk_bf16(p0[6], p0[7]);
            w1.x = cvt_pk_bf16(p0[8], p0[9]); w1.y = cvt_pk_bf16(p0[10], p0[11]); w1.z = cvt_pk_bf16(p0[12], p0[13]); w1.w = cvt_pk_bf16(p0[14], p0[15]);
            w2.x = cvt_pk_bf16(p1[0], p1[1]); w2.y = cvt_pk_bf16(p1[2], p1[3]); w2.z = cvt_pk_bf16(p1[4], p1[5]); w2.w = cvt_pk_bf16(p1[6], p1[7]);
            w3.x = cvt_pk_bf16(p1[8], p1[9]); w3.y = cvt_pk_bf16(p1[10], p1[11]); w3.z = cvt_pk_bf16(p1[12], p1[13]); w3.w = cvt_pk_bf16(p1[14], p1[15]);
            attn_pv(o, vb, __builtin_bit_cast(bf16x8, w0), __builtin_bit_cast(bf16x8, w1), __builtin_bit_cast(bf16x8, w2), __builtin_bit_cast(bf16x8, w3));
        }
    }
    lrow += __shfl_xor(lrow, 32);
    if (hi == 0) wsf[32 + r32] = 1.0f / lrow;
    LDS_WAIT();
#pragma unroll
    for (int r = 0; r < 16; ++r) { const int qr_ = crow(r, hi); const float il = wsf[32 + qr_];
        bf16_t* op = Op + (size_t)(qw0 + qr_) * ldo + r32;
        op[0] = (bf16_t)f2bf(o[0][r] * il); op[32] = (bf16_t)f2bf(o[1][r] * il); }
}
__device__ __forceinline__ void swa_unit(LAS unsigned char* lds, const bf16_t* __restrict__ QS, const bf16_t* __restrict__ KS, const bf16_t* __restrict__ VS, bf16_t* __restrict__ OS, const float* __restrict__ sinks, int b, int g, int n) {
    int tid = threadIdx.x; asm volatile("" : "+v"(tid));
    const int lane = tid & 63, r32 = lane & 31, hi = lane >> 5; const int wid = __builtin_amdgcn_readfirstlane(tid >> 6);
    LAS unsigned char* Kl = lds; LAS unsigned char* Vl = lds + 49152; LAS float* wsf = (LAS float*)(lds + 98304) + wid * 64; LAS bf16_t* stg = (LAS bf16_t*)(lds + 100352) + wid * 1024;
    const int kbase = 256 * n - 128;
    const bf16_t* Kp = KS + (size_t)b * SEQ * 128 + g * 64; const bf16_t* Vp = VS + (size_t)b * SEQ * 128 + g * 64;
    { u32x4 kv[6], vv[6];
#pragma unroll
      for (int t = 0; t < 6; ++t) { const int p0 = kbase + 64 * t; const int pk = p0 < 0 ? 0 : p0;
          kv[t] = *(const u32x4*)(Kp + (size_t)(pk + lane) * 128 + wid * 8);
          vv[t] = *(const u32x4*)(Vp + (size_t)(pk + 16 * (wid & 3) + (lane >> 2)) * 128 + (wid >> 2) * 32 + (lane & 3) * 8); }
#pragma unroll
      for (int t = 0; t < 6; ++t) { *(LAS u32x4*)(Kl + t * 8192 + wid * 1024 + lane * 16) = kv[t]; *(LAS u32x4*)(Vl + t * 8192 + wid * 1024 + lane * 16) = vv[t]; } }
    const int h = 4 * g + (wid >> 1);
    const float sink2 = sinks[h] * LOG2E;
    const bf16_t* Qp = QS + (size_t)b * SEQ * 512 + h * 64; bf16_t* Op = OS + (size_t)b * SEQ * 1024 + h * 64;
    bf16x8 qr[4][4];
#pragma unroll
    for (int i = 0; i < 4; ++i) { const int qpos = 256 * n + 128 * (wid & 1) + 32 * i + r32;
#pragma unroll
        for (int d0 = 0; d0 < 4; ++d0) qr[i][d0] = *(const bf16x8*)(Qp + (size_t)qpos * 512 + d0 * 16 + hi * 8); }
    __syncthreads();
#pragma unroll
    for (int i = 0; i < 4; ++i) {
        const int r0 = 128 * (wid & 1) + 32 * i, qpos = 256 * n + r0 + r32;
        float mrow = sink2, lrow = (hi == 0) ? 1.f : 0.f;
        f32x16 o[2];
#pragma unroll
        for (int r = 0; r < 16; ++r) { o[0][r] = 0.f; o[1][r] = 0.f; }
        const int j0 = (r0 + 1) >> 6;
#pragma unroll 1
        for (int j = j0; j < j0 + 3; ++j) {
            const int kp0 = kbase + 64 * j;
            if (kp0 < 0) continue;
            f32x16 p0, p1;
#pragma unroll
            for (int r = 0; r < 16; ++r) { p0[r] = 0.f; p1[r] = 0.f; }
            { const LAS unsigned char* kb = Kl + j * 8192 + hi * 1024 + r32 * 16;
#pragma unroll
              for (int d0 = 0; d0 < 4; ++d0) { const bf16x8 b0 = *(const LAS bf16x8*)(kb + d0 * 2048), b1 = *(const LAS bf16x8*)(kb + d0 * 2048 + 512);
                  p0 = __builtin_amdgcn_mfma_f32_32x32x16_bf16(b0, qr[i][d0], p0, 0, 0, 0); p1 = __builtin_amdgcn_mfma_f32_32x32x16_bf16(b1, qr[i][d0], p1, 0, 0, 0); } }
            float rm = -1e30f;
#pragma unroll
            for (int r = 0; r < 16; ++r) { const int kv0 = kp0 + crow(r, hi), kv1 = kv0 + 32;
                const bool v0 = (kv0 <= qpos) && (qpos - kv0 < WINDOW), v1 = (kv1 <= qpos) && (qpos - kv1 < WINDOW);
                const float s0 = v0 ? p0[r] : -1e30f, s1 = v1 ? p1[r] : -1e30f; p0[r] = s0; p1[r] = s1; rm = fmaxf(rm, fmaxf(s0, s1)); }
            rm = fmaxf(rm, __shfl_xor(rm, 32));
            const float mnew = fmaxf(mrow, rm); const float f = __builtin_amdgcn_exp2f(mrow - mnew); mrow = mnew;
            float ls = 0.f;
#pragma unroll
            for (int r = 0; r < 16; ++r) { p0[r] = __builtin_amdgcn_exp2f(p0[r] - mnew); p1[r] = __builtin_amdgcn_exp2f(p1[r] - mnew); ls += p0[r] + p1[r]; }
            lrow = lrow * f + ls;
            if (__any(f != 1.0f)) {
                if (hi == 0) wsf[r32] = f;
                LDS_WAIT();
#pragma unroll
                for (int r = 0; r < 16; ++r) { const float fr_ = wsf[crow(r, hi)]; o[0][r] *= fr_; o[1][r] *= fr_; }
            }
            u32x4 w0, w1, w2, w3;
            w0.x = cvt_pk_bf16(p0[0], p0[1]); w0.y = cvt_pk_bf16(p0[2], p0[3]); w0.z = cvt_pk_bf16(p0[4], p0[5]); w0.w = cvt_pk_bf16(p0[6], p0[7]);
            w1.x = cvt_pk_bf16(p0[8], p0[9]); w1.y = cvt_pk_bf16(p0[10], p0[11]); w1.z = cvt_pk_bf16(p0[12], p0[13]); w1.w = cvt_pk_bf16(p0[14], p0[15]);
            w2.x = cvt_pk_bf16(p1[0], p1[1]); w2.y = cvt_pk_bf16(p1[2], p1[3]); w2.z = cvt_pk_bf16(p1[4], p1[5]); w2.w = cvt_pk_bf16(p1[6], p1[7]);
            w3.x = cvt_pk_bf16(p1[8], p1[9]); w3.y = cvt_pk_bf16(p1[10], p1[11]); w3.z = cvt_pk_bf16(p1[12], p1[13]); w3.w = cvt_pk_bf16(p1[14], p1[15]);
            const int vb = (int)(unsigned)(uintptr_t)(Vl + j * 8192) + ((lane >> 4) & 1) * 32 + (lane & 3) * 8 + (4 * hi + ((lane & 15) >> 2)) * 64;
            attn_pv(o, vb, __builtin_bit_cast(bf16x8, w0), __builtin_bit_cast(bf16x8, w1), __builtin_bit_cast(bf16x8, w2), __builtin_bit_cast(bf16x8, w3));
        }
        lrow += __shfl_xor(lrow, 32);
        if (hi == 0) wsf[32 + r32] = 1.0f / lrow;
        LDS_WAIT();
        float il[16];
#pragma unroll
        for (int r = 0; r < 16; ++r) il[r] = wsf[32 + crow(r, hi)];
#pragma unroll
        for (int d0 = 0; d0 < 2; ++d0) {
#pragma unroll
            for (int r = 0; r < 16; ++r) stg[crow(r, hi) * 32 + r32] = (bf16_t)f2bf(o[d0][r] * il[r]);
            LDS_WAIT();
#pragma unroll
            for (int q = 0; q < 2; ++q) { const int row = q * 16 + (lane >> 2), ch = lane & 3; const u32x4 vv_ = *(const LAS u32x4*)(stg + row * 32 + ch * 8);
                *(u32x4*)(Op + (size_t)(256 * n + r0 + row) * 1024 + d0 * 32 + ch * 8) = vv_; }
            LDS_WAIT(); }
    }
    __syncthreads();
}
__device__ __forceinline__ void p2_attention(const Frame& F, const Args& a) {
    unsigned char* ws = F.ws; const float* sinks = (const float*)a.in[6];
    const bf16_t* QF = (const bf16_t*)(ws + WS_QF); const bf16_t* KF = (const bf16_t*)(ws + WS_KF); const bf16_t* VF = (const bf16_t*)(ws + WS_VF);
    const bf16_t* QS = (const bf16_t*)(ws + WS_QS); const bf16_t* KS = (const bf16_t*)(ws + WS_KS); const bf16_t* VS = (const bf16_t*)(ws + WS_VS);
    bf16_t* OF = (bf16_t*)(ws + WS_R1); bf16_t* OS = OF + 512; const float* cum = (const float*)(ws + WS_CUM);
    unsigned* queue = (unsigned*)(ws + WS_CTL + CTL_QUEUE_OFF); const unsigned* nrm = (const unsigned*)(ws + WS_CTL + CTL_NRM_OFF);
    volatile LAS int* qslot = (volatile LAS int*)(F.lds + MISC_OFF + 4096);
#pragma unroll 1
    for (;;) {
        if (threadIdx.x == 0) *qslot = (int)atomicAdd(queue, 1u);
        __syncthreads();
        const int u = __builtin_amdgcn_readfirstlane(*qslot);
        const int C0 = (F.G == 256) ? 128 : 0, NCQ = W13_CHUNKS + W2_CHUNKS - C0;
        if (u >= NCQ + 1024 + 256) break;
        int f = -1, c = -1, v = -1;
        if (u < 2 * NCQ) { if (u & 1) { const int ci = u >> 1; c = ci < W13_CHUNKS ? W2_CHUNKS + ci : C0 + (ci - W13_CHUNKS); } else f = u >> 1; }
        else if (u < 2 * NCQ + 256) v = u - 2 * NCQ;
        else f = u - NCQ - 256;
        if (f >= 0) { const int qb = 31 - (f >> 5), bh = f & 31;
            attn_body::attn_unit<64>(bh >> 3, bh & 7, qb, (const attn_body::bf16*)QF, (const attn_body::bf16*)KF, (const attn_body::bf16*)VF, (attn_body::bf16*)OF, cum, nrm, (char*)F.lds); }
        else if (c >= 0) { if (c < W2_CHUNKS) w2_convert_chunk(F, a, c); else w13q_convert_chunk(F, a, c - W2_CHUNKS); __syncthreads(); }
        else { swa_unit(F.lds, QS, KS, VS, OS, sinks, v >> 6, (v >> 5) & 1, v & 31); }
    }
    __syncthreads();
}

__device__ __forceinline__ void p5_router(const Frame& F, const Args& a) {
    unsigned char* ws = F.ws; const bf16_t* x1 = (const bf16_t*)(ws + WS_X1B); const float* ffn_norm = (const float*)a.in[10]; const float* b_group = (const float*)a.in[12]; const float* b_expert = (const float*)a.in[14];
    signed char* H2 = (signed char*)(ws + WS_R1); float* saL = (float*)(ws + WS_SAL); const bf16_t* WrH = (const bf16_t*)(ws + WS_WR); const bf16_t* WrL = WrH + 80 * 1024;
    int* cnt = (int*)(ws + WS_CTL); int* list = (int*)(ws + WS_LIST); float* gate = (float*)(ws + WS_GATE);
    constexpr int WROW = 272, WMAT = 80 * WROW, WBUF = 2 * WMAT;
    LAS unsigned char* WB = F.lds; LAS float* GN = (LAS float*)(F.lds + 2 * WBUF); LAS float* LG = (LAS float*)(F.lds + 2 * WBUF + 4096) + F.wave * (16 * 80);
    const int fr = F.lane & 15, fq = F.lane >> 4;
    LAS int* lcnt = (LAS int*)(F.lds + MISC_OFF + 3072); LAS int* lbase = lcnt + 64;
    if (F.tid < NE) lcnt[F.tid] = 0;
    for (int idx = F.tid; idx < 256; idx += NTHREADS) *(LAS f32x4*)(GN + idx * 4) = *(const f32x4*)(ffn_norm + idx * 4);
    __syncthreads();
    const bf16_t* wsrc = WrH + (size_t)(F.tid >> 4) * 1024 + (F.tid & 15) * 8; LAS unsigned char* wdst = WB + (F.tid >> 4) * WROW + (F.tid & 15) * 16;
#define P5_WLOAD(dst, kc) do { _Pragma("unroll") for (int i_ = 0; i_ < 5; ++i_) dst[i_] = *(const u32x4*)(wsrc + i_ * 32 * 1024 + (kc) * 128); } while (0)
#define P5_WSTORE(src, buf) do { _Pragma("unroll") for (int i_ = 0; i_ < 5; ++i_) *(LAS u32x4*)(wdst + (buf) * WBUF + i_ * 32 * WROW) = src[i_]; } while (0)
#define P5_XLOAD(dst, kc) do { _Pragma("unroll") for (int s_ = 0; s_ < 4; ++s_) dst[s_] = *(const u32x4*)(xrow + (kc) * 128 + s_ * 32); } while (0)
#pragma unroll 1
    for (int chunk = F.vcu; chunk < T / 128; chunk += F.G) {
        const int row = chunk * 128 + F.wave * 16 + fr;
        const bf16_t* xrow = x1 + (size_t)row * DM + fq * 8;
        u32x4 wreg[5]; u32x4 xa[4], xn[4];
        P5_WLOAD(wreg, 0);
        float ss = 0.f; float am = 0.f;
#pragma unroll 16
        for (int s = 0; s < 32; ++s) { const u32x4 w = *(const u32x4*)(xrow + 32 * s);
            const f32x4 g0 = *(const LAS f32x4*)(GN + 32 * s + fq * 8), g1 = *(const LAS f32x4*)(GN + 32 * s + fq * 8 + 4);
            ss += (BFLO(w.x) * BFLO(w.x) + BFHI(w.x) * BFHI(w.x)) + (BFLO(w.y) * BFLO(w.y) + BFHI(w.y) * BFHI(w.y)) + (BFLO(w.z) * BFLO(w.z) + BFHI(w.z) * BFHI(w.z)) + (BFLO(w.w) * BFLO(w.w) + BFHI(w.w) * BFHI(w.w));
            am = fmaxf(am, fmaxf(fmaxf(fabsf(BFLO(w.x) * g0.x), fabsf(BFHI(w.x) * g0.y)), fmaxf(fabsf(BFLO(w.y) * g0.z), fabsf(BFHI(w.y) * g0.w))));
            am = fmaxf(am, fmaxf(fmaxf(fabsf(BFLO(w.z) * g1.x), fabsf(BFHI(w.z) * g1.y)), fmaxf(fabsf(BFLO(w.w) * g1.z), fabsf(BFHI(w.w) * g1.w)))); }
        ss += __shfl_xor(ss, 16); ss += __shfl_xor(ss, 32);
        am = fmaxf(am, __shfl_xor(am, 16)); am = fmaxf(am, __shfl_xor(am, 32));
        const float rstd = 1.0f / sqrtf(ss * (1.0f / DM) + EPS);
        const float hmax = am * rstd * 1.0001f;
        const float qinv = hmax > 0.f ? 127.0f / hmax : 0.f;
        P5_XLOAD(xa, 0);
        __syncthreads();
        P5_WSTORE(wreg, 0);
        f32x4 acc[5];
#pragma unroll
        for (int n = 0; n < 5; ++n) acc[n] = (f32x4){0.f, 0.f, 0.f, 0.f};
#pragma unroll 1
        for (int kc = 0; kc < 8; ++kc) {
            if (kc < 7) { P5_WLOAD(wreg, kc + 1); P5_XLOAD(xn, kc + 1); }
            __syncthreads();
            const LAS unsigned char* WH = WB + (kc & 1) * WBUF; const LAS unsigned char* WL = WH + WMAT;
#pragma unroll
            for (int s4 = 0; s4 < 4; ++s4) { const int k0 = kc * 128 + s4 * 32 + fq * 8;
                const f32x4 g0 = *(const LAS f32x4*)(GN + k0), g1 = *(const LAS f32x4*)(GN + k0 + 4);
                const u32x4 xw = xa[s4]; const f32x4 x0 = {BFLO(xw.x), BFHI(xw.x), BFLO(xw.y), BFHI(xw.y)}, x1v = {BFLO(xw.z), BFHI(xw.z), BFLO(xw.w), BFHI(xw.w)};
                const f32x4 h0 = x0 * rstd * g0, h1 = x1v * rstd * g1;
                const u32x4 hh = pack8(h0, h1);
                f32x4 r0, r1;
                r0[0] = h0[0] - bf2f(hh.x & 0xffffu); r0[1] = h0[1] - bf2f(hh.x >> 16); r0[2] = h0[2] - bf2f(hh.y & 0xffffu); r0[3] = h0[3] - bf2f(hh.y >> 16);
                r1[0] = h1[0] - bf2f(hh.z & 0xffffu); r1[1] = h1[1] - bf2f(hh.z >> 16); r1[2] = h1[2] - bf2f(hh.w & 0xffffu); r1[3] = h1[3] - bf2f(hh.w >> 16);
                const u32x4 hl = pack8(r0, r1);
                { unsigned lo = 0u, hi_ = 0u;
#pragma unroll
                  for (int q = 0; q < 4; ++q) { lo |= ((unsigned)(int)__builtin_rintf(h0[q] * qinv) & 0xffu) << (8 * q); hi_ |= ((unsigned)(int)__builtin_rintf(h1[q] * qinv) & 0xffu) << (8 * q); }
                  u32x2 qw; qw.x = lo; qw.y = hi_; *(u32x2*)(H2 + (size_t)row * DM + k0) = qw; }
                const bf16x8 ah = __builtin_bit_cast(bf16x8, hh), al = __builtin_bit_cast(bf16x8, hl);
#pragma unroll
                for (int n = 0; n < 5; ++n) { const int bo = (n * 16 + fr) * WROW + (s4 * 32 + fq * 8) * 2;
                    const bf16x8 bh = *(const LAS bf16x8*)(WH + bo), bl = *(const LAS bf16x8*)(WL + bo);
                    acc[n] = __builtin_amdgcn_mfma_f32_16x16x32_bf16(ah, bh, acc[n], 0, 0, 0);
                    acc[n] = __builtin_amdgcn_mfma_f32_16x16x32_bf16(al, bh, acc[n], 0, 0, 0);
                    acc[n] = __builtin_amdgcn_mfma_f32_16x16x32_bf16(ah, bl, acc[n], 0, 0, 0); } }
            if (kc < 7) { P5_WSTORE(wreg, (kc + 1) & 1);
#pragma unroll
                for (int i = 0; i < 4; ++i) xa[i] = xn[i]; }
        }
#pragma unroll
        for (int n = 0; n < 5; ++n)
#pragma unroll
            for (int r = 0; r < 4; ++r) LG[(4 * fq + r) * 80 + n * 16 + fr] = acc[n][r];
        LDS_WAIT();
        int e0 = 0, e1 = 0, q0 = 0, q1 = 0, tok_ = 0; float g0_ = 0.f, g1_ = 0.f;
        if (F.lane < 16) {
            const int tok = chunk * 128 + F.wave * 16 + F.lane; const LAS float* lg = LG + F.lane * 80;
            float gl[8]; float gm = -1e30f; int gi = 0;
#pragma unroll
            for (int j = 0; j < 8; ++j) { gl[j] = lg[j] + b_group[j]; if (gl[j] > gm) { gm = gl[j]; gi = j; } }
            float den = 0.f;
#pragma unroll
            for (int j = 0; j < 8; ++j) den += __expf(gl[j] - gm);
            const float gw = 1.0f / den;
            float v0 = -1e30f, v1 = -1e30f; int i0 = 0, i1 = 0;
#pragma unroll
            for (int j = 0; j < 8; ++j) { const float e = lg[8 + gi * 8 + j] + b_expert[gi * 8 + j];
                if (e > v0) { v1 = v0; i1 = i0; v0 = e; i0 = j; } else if (e > v1) { v1 = e; i1 = j; } }
            const float ex = __expf(v1 - v0); const float p0 = 1.0f / (1.0f + ex);
            e0 = gi * 8 + i0; e1 = gi * 8 + i1; tok_ = tok;
            q0 = __hip_atomic_fetch_add(&lcnt[e0], 1, __ATOMIC_RELAXED, __HIP_MEMORY_SCOPE_WORKGROUP); q1 = __hip_atomic_fetch_add(&lcnt[e1], 1, __ATOMIC_RELAXED, __HIP_MEMORY_SCOPE_WORKGROUP);
            g0_ = gw * p0; g1_ = gw * ex * p0;
        }
        __syncthreads();
        if (F.tid < NE) { const int c = lcnt[F.tid]; lbase[F.tid] = c ? atomicAdd(&cnt[F.tid * 64], c) : 0; lcnt[F.tid] = 0; }
        __syncthreads();
        if (F.lane < 16) { const size_t i0_ = (size_t)e0 * T + lbase[e0] + q0, i1_ = (size_t)e1 * T + lbase[e1] + q1; list[i0_] = tok_ * 2; list[i1_] = tok_ * 2 + 1; gate[i0_] = g0_; gate[i1_] = g1_; saL[i0_] = hmax * (1.0f / 127.0f); saL[i1_] = hmax * (1.0f / 127.0f); }
    }
#undef P5_WLOAD
#undef P5_WSTORE
#undef P5_XLOAD
    __syncthreads();
}

__device__ __forceinline__ void p8_final(const Frame& F, const Args& a) {
    const float* final_norm = (const float*)a.in[18]; float* out = a.out; const bf16_t* Y = (const bf16_t*)(F.ws + WS_YBUF); const bf16_t* X1 = (const bf16_t*)(F.ws + WS_X1B);
    const int gw = F.vcu * NWAVES + F.wave, NGW = F.G * NWAVES;
    f32x4 gv[4];
#pragma unroll
    for (int j = 0; j < 2; ++j) { gv[2 * j] = *(const f32x4*)(final_norm + 8 * F.lane + 512 * j); gv[2 * j + 1] = *(const f32x4*)(final_norm + 8 * F.lane + 512 * j + 4); }
    constexpr int R = 2;
    for (int m0 = gw * R; m0 < T; m0 += NGW * R) {
        u32x4 xw[R][2], ya[R][2], yb[R][2];
#pragma unroll
        for (int r = 0; r < R; ++r)
#pragma unroll
            for (int j = 0; j < 2; ++j) { const size_t m = m0 + r; const int co = 8 * F.lane + 512 * j;
                xw[r][j] = *(const u32x4*)(X1 + m * DM + co); ya[r][j] = *(const u32x4*)(Y + (2 * m) * DM + co); yb[r][j] = *(const u32x4*)(Y + (2 * m + 1) * DM + co); }
#pragma unroll
        for (int r = 0; r < R; ++r) {
            f32x4 v[4]; float ss = 0.f;
#pragma unroll
            for (int j = 0; j < 2; ++j) { const u32x4 x = xw[r][j], p = ya[r][j], q = yb[r][j];
                v[2 * j] = (f32x4){BFLO(x.x) + BFLO(p.x) + BFLO(q.x), BFHI(x.x) + BFHI(p.x) + BFHI(q.x), BFLO(x.y) + BFLO(p.y) + BFLO(q.y), BFHI(x.y) + BFHI(p.y) + BFHI(q.y)};
                v[2 * j + 1] = (f32x4){BFLO(x.z) + BFLO(p.z) + BFLO(q.z), BFHI(x.z) + BFHI(p.z) + BFHI(q.z), BFLO(x.w) + BFLO(p.w) + BFLO(q.w), BFHI(x.w) + BFHI(p.w) + BFHI(q.w)}; }
#pragma unroll
            for (int i = 0; i < 4; ++i) ss += (v[i].x * v[i].x + v[i].y * v[i].y) + (v[i].z * v[i].z + v[i].w * v[i].w);
            const float rstd = 1.0f / sqrtf(wave_sum(ss) * (1.0f / DM) + EPS);
            float* orow = out + (size_t)(m0 + r) * DM + 8 * F.lane;
#pragma unroll
            for (int j = 0; j < 2; ++j) { *(f32x4*)(orow + 512 * j) = v[2 * j] * rstd * gv[2 * j]; *(f32x4*)(orow + 512 * j + 4) = v[2 * j + 1] * rstd * gv[2 * j + 1]; }
        }
    }
}

__device__ __forceinline__ MoeTab moe_table(const Frame& F) {
    LAS int* pre = (LAS int*)(F.lds + MISC_OFF + 2048); LAS int* cn = pre + 80;
    const int* cnt = (const int*)(F.ws + WS_CTL);
    __syncthreads();
    if (F.tid < 64) {
        const int c = cnt[F.lane * 64]; const int nb = (c + 255) >> 8; int inc = nb;
#pragma unroll
        for (int o = 1; o < 64; o <<= 1) { const int t = __shfl_up(inc, o); if (F.lane >= o) inc += t; }
        pre[F.lane] = inc - nb; cn[F.lane] = c;
        if (F.lane == 63) { pre[NE] = inc; pre[NE + 1] = 0x7fffffff; } }
    __syncthreads();
    MoeTab tb; tb.pre = pre; tb.cnt = cn; return tb;
}

#define XB_TMO      128
#define XB_XCNT(j)  (256  + 64 * (j))
#define XB_XSUB(j)  (1280 + 64 * (j))
#define XB_XGEN(j)  (2304 + 64 * (j))
#define XB_TOP      3328
#define XB_TOPGEN   3392
#define XCD_BAR_WORDS 3456
#define XB_SPIN_CAP (1u << 18)

__device__ __forceinline__ unsigned xb_ld(unsigned* p)              { return __hip_atomic_load(p, __ATOMIC_RELAXED, __HIP_MEMORY_SCOPE_AGENT); }
__device__ __forceinline__ unsigned xb_add(unsigned* p, unsigned v) { return __hip_atomic_fetch_add(p, v, __ATOMIC_RELAXED, __HIP_MEMORY_SCOPE_AGENT); }
__device__ __forceinline__ unsigned xb_xcc_id() { return (unsigned)__builtin_amdgcn_s_getreg((3 << 11) | 20) & 0xFu; }
#define XB_SPIN(cond, bar) do { unsigned _sp = 0; while (cond) { __builtin_amdgcn_s_sleep(1); \
    if ((++_sp & 255u) == 0u) { if (xb_ld(&(bar)[XB_TMO])) break; if (_sp > XB_SPIN_CAP) { atomicAdd(&(bar)[XB_TMO], 1u); break; } } } } while (0)

struct XcdBarrier {
    unsigned* bar; unsigned x;
    volatile LAS unsigned* st;
};

__device__ __forceinline__ XcdBarrier xcd_barrier_post(unsigned* bar, volatile LAS unsigned* st) {
    XcdBarrier b; b.bar = bar; b.x = xb_xcc_id(); b.st = st;
    if (threadIdx.x == 0) (void)xb_add(&bar[XB_XCNT(b.x)], 1u);
    return b;
}
__device__ __forceinline__ void xcd_barrier_complete(unsigned* bar, unsigned x, unsigned& nloc, unsigned& nx) {
    const unsigned G = gridDim.x * gridDim.y * gridDim.z;
    unsigned sum, cnt, mine, sp = 0u;
    for (;;) {
        sum = 0u; cnt = 0u; mine = 0u;
#pragma unroll
        for (unsigned j = 0; j < 16; ++j) { const unsigned c = xb_ld(&bar[XB_XCNT(j)]); sum += c; cnt += (c > 0u) ? 1u : 0u; mine = (j == x) ? c : mine; }
        if (sum == G) break;
        __builtin_amdgcn_s_sleep(1);
        if ((++sp & 255u) == 0u) { if (xb_ld(&bar[XB_TMO])) break; if (sp > XB_SPIN_CAP) { atomicAdd(&bar[XB_TMO], 1u); break; } }
    }
    nloc = mine > 0u ? mine : 1u; nx = cnt > 0u ? cnt : 1u;
}

__device__ __forceinline__ void xcd_barrier(const XcdBarrier& b) {
    asm volatile("s_waitcnt vmcnt(0)" ::: "memory");
    __syncthreads();
    if (threadIdx.x == 0) {
        unsigned* bar = b.bar;
        __builtin_amdgcn_s_waitcnt(0);
        unsigned nloc = b.st[0], nx = b.st[1];
        if (nloc == 0u) { xcd_barrier_complete(bar, b.x, nloc, nx); b.st[0] = nloc; b.st[1] = nx; }
        const unsigned old = xb_add(&bar[XB_XSUB(b.x)], 1u);
        const unsigned gen = old / nloc;
        if (old + 1u == (gen + 1u) * nloc) {
            __builtin_amdgcn_fence(__ATOMIC_RELEASE, "agent");
            asm volatile("s_waitcnt vmcnt(0)" ::: "memory");
            const unsigned og = xb_add(&bar[XB_TOP], 1u);
            const unsigned tg = og / nx;
            if (og + 1u == (tg + 1u) * nx) xb_add(&bar[XB_TOPGEN], 1u);
            else XB_SPIN(xb_ld(&bar[XB_TOPGEN]) == tg, bar);
            __builtin_amdgcn_fence(__ATOMIC_ACQUIRE, "agent");
            xb_add(&bar[XB_XGEN(b.x)], 1u);
            asm volatile("s_waitcnt vmcnt(0)" ::: "memory");
        } else {
            XB_SPIN(xb_ld(&bar[XB_XGEN(b.x)]) == gen, bar);
            __builtin_amdgcn_fence(__ATOMIC_ACQUIRE, "agent");
            asm volatile("s_waitcnt vmcnt(0)" ::: "memory");
        }
    }
    __syncthreads();
}

constexpr int NPHASE = 9;
__global__ void __launch_bounds__(NTHREADS, 2) fwd_kernel(Args a) {
    extern __shared__ __attribute__((aligned(16))) unsigned char lds_raw[];
    Frame F; F.lds = (LAS unsigned char*)lds_raw; F.tid = threadIdx.x; F.lane = F.tid & 63; F.wave = __builtin_amdgcn_readfirstlane(F.tid >> 6);
    F.G = gridDim.x; { const int bx = blockIdx.x; F.vcu = (F.G % 8 == 0) ? (bx % 8) * (F.G / 8) + bx / 8 : bx; } F.ws = a.ws;
    unsigned char* ws = a.ws;
    const int lo = a.ph_lo, hi = a.ph_hi;
    volatile LAS unsigned* MISC = (volatile LAS unsigned*)(F.lds + MISC_OFF);
    if (F.tid < 64) MISC[F.tid] = 0u;
    __syncthreads();
    XcdBarrier bar; bar.bar = (unsigned*)(ws + WS_CTL + CTL_BAR_OFF); bar.x = 0; bar.st = nullptr;
    if (a.coop) bar = xcd_barrier_post((unsigned*)(ws + WS_CTL + CTL_BAR_OFF), MISC + 8);
#define IN(k) (lo <= (k) && (k) < hi)
#define REFRESH() do { int t_ = threadIdx.x; asm volatile("" : "+v"(t_)); F.tid = t_; F.lane = t_ & 63; F.wave = __builtin_amdgcn_readfirstlane(t_ >> 6); } while (0)
    if (a.coop == 2) cg::this_grid().sync();
#define SEAM(k) do { if (IN(k) && IN((k) + 1)) { xcd_barrier(bar); } } while (0)
    if (IN(0)) { REFRESH(); p0_prologue(F, a); }
    SEAM(0);
    if (IN(1)) {
        if (blockIdx.x >= 128 && blockIdx.x < 160) { REFRESH(); cumsum_block(F, blockIdx.x - 128); }
        SchedDense S; S.A = (const char*)(ws + WS_R1); S.B = (const char*)(ws + WS_WIN_T); S.lda = 1024; S.ldb = 1024; S.nM = T / 256; S.nN = NP1 / 256; S.G = F.G; S.c = blockIdx.x;
        EpiInProj E; E.ws = ws;
        E.nrm = (unsigned*)(ws + WS_CTL + CTL_NRM_OFF); E.G = (unsigned char*)a.out; E.rope = (const float*)(ws + WS_ROPE); E.bgate = (const float*)a.in[5];
        pg8::gemm_phase(F.lds, 1024, S, E);
        if (F.G == 256 && blockIdx.x >= 128) { w2_convert_chunk(F, a, (int)blockIdx.x - 128); __syncthreads(); }
    }
    SEAM(1);
    if (IN(2)) { REFRESH(); p2_attention(F, a); }
    SEAM(2);
    if (IN(3)) {
        SchedDense S; S.A = (const char*)(ws + WS_R1); S.B = (const char*)(ws + WS_WPF_T); S.lda = 1024; S.ldb = 1024; S.nM = T / 256; S.nN = 4; S.G = F.G; S.c = blockIdx.x;
        EpiProjF E; E.M = (bf16_t*)(ws + WS_MERGED); E.G = (const unsigned char*)a.out;
        pg8::gemm_phase(F.lds, 1024, S, E);
    }
    SEAM(3);
    if (IN(4)) {
        SchedDense S; S.A = (const char*)(ws + WS_MERGED); S.B = (const char*)(ws + WS_WOUT_T); S.lda = 1024; S.ldb = 1024; S.nM = T / 256; S.nN = 4; S.G = F.G; S.c = blockIdx.x;
        EpiOut E; E.X = (const float*)a.in[0]; E.O = (bf16_t*)(ws + WS_X1B);
        pg8::gemm_phase(F.lds, 1024, S, E);
    }
    SEAM(4);
    if (IN(5)) { REFRESH(); p5_router(F, a); }
    SEAM(5);
    if (IN(6)) {
        REFRESH(); const MoeTab tb = moe_table(F);
        SchedMoe1 S; S.A = (const char*)(ws + WS_R1); S.B = (const char*)(ws + WS_W13T); S.list = (const int*)(ws + WS_LIST); S.lda = 1024; S.ldb = 1024; S.G = F.G; S.v = F.vcu; S.tb = tb;
        EpiMoe1 E; E.H = (bf16_t*)a.out; E.saL = (const float*)(ws + WS_SAL); E.wsc = (const float*)(ws + WS_WSC);
        pg8::gemm_phase(F.lds, 1024, S, E);
    }
    SEAM(6);
    if (IN(7)) {
        REFRESH(); const MoeTab tb = moe_table(F);
        SchedMoe2 S; S.A = (const char*)a.out; S.B = (const char*)(ws + WS_W2T); S.lda = 512; S.ldb = 512; S.G = F.G; S.v = F.vcu; S.tb = tb;
        EpiMoe2 E; E.Y = (bf16_t*)(ws + WS_YBUF); E.list = (const int*)(ws + WS_LIST); E.gate = (const float*)(ws + WS_GATE);
        pg8::gemm_phase(F.lds, 512, S, E);
    }
    SEAM(7);
    if (IN(8)) { REFRESH(); p8_final(F, a); }
#undef IN
#undef SEAM
}

#ifndef MK_N_LAUNCHES
#define MK_N_LAUNCHES 1
#endif
extern "C" void kernel_launch(void* const* d_in, const int* in_sizes, int n_in, void* d_out, int out_size, void* d_ws, size_t ws_size, hipStream_t stream) {
    static int grid = 0;
    if (grid == 0) {
        if (n_in != 19 || in_sizes[0] != T * DM || out_size != T * DM || ws_size < WS_END) { fprintf(stderr, "kernel_launch: unexpected shapes (n_in %d, in0 %d, out %d, ws %zu < %zu)\n", n_in, n_in > 0 ? in_sizes[0] : -1, out_size, ws_size, (size_t)WS_END); grid = -1; return; }
        int dev = 0, cus = 0, per_cu = 0;
        if (hipGetDevice(&dev) != hipSuccess || hipDeviceGetAttribute(&cus, hipDeviceAttributeMultiprocessorCount, dev) != hipSuccess) { grid = -1; return; }
        if (hipFuncSetAttribute((const void*)fwd_kernel, hipFuncAttributeMaxDynamicSharedMemorySize, LDS_BYTES) != hipSuccess) { fprintf(stderr, "kernel_launch: hipFuncSetAttribute failed\n"); grid = -1; return; }
        if (hipOccupancyMaxActiveBlocksPerMultiprocessor(&per_cu, (const void*)fwd_kernel, NTHREADS, LDS_BYTES) != hipSuccess || per_cu < 1) { fprintf(stderr, "kernel_launch: occupancy query failed (%d)\n", per_cu); (void)hipGetLastError(); grid = -1; return; }
        grid = cus;
    }
    if (grid < 0) return;
    (void)hipMemsetAsync((char*)d_ws + WS_CTL, 0, CTL_ZERO_BYTES, stream);
    Args a{};
    for (int i = 0; i < 19; ++i) a.in[i] = d_in[i];
    a.out = (float*)d_out; a.ws = (unsigned char*)d_ws; a.coop = 0; a.pad = 0;
#if MK_N_LAUNCHES == 1
    a.ph_lo = 0; a.ph_hi = NPHASE; a.coop = 1;
    void* args[] = {&a};
    hipError_t e = hipLaunchCooperativeKernel((const void*)fwd_kernel, dim3(grid), dim3(NTHREADS), args, LDS_BYTES, stream);
    if (e != hipSuccess) fprintf(stderr, "cooperative launch failed: %s (grid %d)\n", hipGetErrorString(e), grid);
#else
    for (int p = 0; p < NPHASE; ++p) { a.ph_lo = p; a.ph_hi = p + 1;
        hipLaunchKernelGGL(fwd_kernel, dim3(grid), dim3(NTHREADS), LDS_BYTES, stream, a); }
#endif
}
```
